# Optimizing an MI355X kernel written in HIP

```python
import jax, jax.numpy as jnp
from jax import lax
import numpy as np

D_MODEL = 2048
BATCH = 4
SEQ = 4096
DEPTH = 4

HEAD_DIM = 128
D_MIX = D_MODEL
NSA_HEADS = (D_MIX // 2) // HEAD_DIM
NSA_KV_HEADS = 2
POOL_WIDTH = D_MIX // 4
POOL_WINDOWS = (2, 4, 8, 16)
POOL_GROUPS = len(POOL_WINDOWS)
POOL_GROUP_DIM = POOL_WIDTH // POOL_GROUPS
FOX_HEADS = (D_MIX // 4) // HEAD_DIM
CMP_BLOCK = 32
CMP_STRIDE = 16
SLC_BLOCK = 64
SLC_TOPK = 16
WINDOW = 512
Q_BLOCK = 128
SLC_Q_BLOCK = 64
D_FF = 5632
N_EXPERTS = 8
TOP_K = 2
D_FF_EXPERT = 3584
RMS_EPS = 1e-6
NEG = -1e30
FORCE_SCORE = 1e9
N_DENSE = (DEPTH + 1) // 2
N_MOE = DEPTH // 2

NSA_Q = NSA_HEADS * HEAD_DIM
NSA_KV = NSA_KV_HEADS * HEAD_DIM
FOX_W = FOX_HEADS * HEAD_DIM
IN_SPLITS = (NSA_Q, 6 * NSA_KV, 3 * NSA_HEADS, POOL_WIDTH, 3 * FOX_W, FOX_HEADS)
D_IN = sum(IN_SPLITS)
SPLIT_POINTS = [int(v) for v in np.cumsum(IN_SPLITS)[:-1]]

kernel_name = 'hymba_nsa_pool_fox_moe_trunk'


def rms_norm(x, g):
    xf = x.astype(jnp.float32)
    y = xf * lax.rsqrt(jnp.mean(xf * xf, axis=-1, keepdims=True) + RMS_EPS)
    return (y * g.astype(jnp.float32)).astype(x.dtype)


def masked_softmax(scores, mask):
    s = jnp.where(mask, scores.astype(jnp.float32), NEG)
    p = jax.nn.softmax(s, axis=-1)
    return jnp.where(mask, p, 0.0)


def to_blocks(a, axis, n):
    s = a.shape
    a = a.reshape(s[:axis] + (s[axis] // n, n) + s[axis + 1:])
    return jnp.moveaxis(a, axis, 0)


def from_blocks(a, axis):
    a = jnp.moveaxis(a, 0, axis)
    s = a.shape
    return a.reshape(s[:axis] + (s[axis] * s[axis + 1],) + s[axis + 2:])


def nsa_mixer(q, kv, gates, cmp_pe, cmp_w1, cmp_w2):
    B, S, _ = q.shape
    G, R, dh = NSA_KV_HEADS, NSA_HEADS // NSA_KV_HEADS, HEAD_DIM
    scale = dh ** -0.5
    qh = q.reshape(B, S, G, R, dh).transpose(0, 2, 3, 1, 4)
    k_c, v_c, k_s, v_s, k_w, v_w = [a.reshape(B, S, G, dh).transpose(0, 2, 1, 3)
                                    for a in jnp.split(kv, 6, axis=-1)]
    t_pos = jnp.arange(S)

    n_cmp = (S - CMP_BLOCK) // CMP_STRIDE + 1
    blk = jnp.arange(n_cmp)[:, None] * CMP_STRIDE + jnp.arange(CMP_BLOCK)[None, :]

    def compress(a, j):
        ab = a[:, :, blk] + cmp_pe[j][None, None, None]
        hid = jax.nn.gelu(ab.reshape(B, G, n_cmp, CMP_BLOCK * dh) @ cmp_w1[j])
        return hid @ cmp_w2[j]

    kc = compress(k_c, 0)
    vc = compress(v_c, 1)
    s_cmp = jnp.einsum('bgrtd,bgcd->bgrtc', qh, kc) * scale
    cmp_end = jnp.arange(n_cmp) * CMP_STRIDE + CMP_BLOCK - 1
    p_cmp = masked_softmax(s_cmp, cmp_end[None, :] <= t_pos[:, None])
    o_cmp = jnp.einsum('bgrtc,bgcd->bgrtd', p_cmp.astype(vc.dtype), vc)

    n_slc = S // SLC_BLOCK
    n_sel = min(SLC_TOPK, n_slc)
    c_idx = jnp.arange(n_cmp)[:, None]
    j_idx = jnp.arange(n_slc)[None, :]
    overlap = ((c_idx * CMP_STRIDE <= j_idx * SLC_BLOCK + SLC_BLOCK - 1) &
               (c_idx * CMP_STRIDE + CMP_BLOCK - 1 >= j_idx * SLC_BLOCK)).astype(jnp.float32)
    imp = jnp.einsum('bgrtc,cj->bgtj', p_cmp, overlap)
    cur = (t_pos // SLC_BLOCK)[:, None]
    valid = j_idx <= cur
    forced = (j_idx == 0) | (j_idx == cur) | (j_idx == cur - 1)
    imp = jnp.where(forced, FORCE_SCORE, jnp.where(valid, imp, -1.0))
    _, sel = lax.top_k(imp, n_sel)

    ks_b = k_s.reshape(B, G, n_slc, SLC_BLOCK, dh)
    vs_b = v_s.reshape(B, G, n_slc, SLC_BLOCK, dh)
    gather = jax.vmap(jax.vmap(lambda blocks, ix: blocks[ix]))
    n_keys = n_sel * SLC_BLOCK

    def slc_block(args):
        q_blk, sel_blk, q0 = args
        kg = gather(ks_b, sel_blk).reshape(B, G, SLC_Q_BLOCK, n_keys, dh)
        vg = gather(vs_b, sel_blk).reshape(B, G, SLC_Q_BLOCK, n_keys, dh)
        key_pos = (sel_blk[..., None] * SLC_BLOCK + jnp.arange(SLC_BLOCK)).reshape(B, G, SLC_Q_BLOCK, n_keys)
        q_pos = q0 + jnp.arange(SLC_Q_BLOCK)
        mask = key_pos <= q_pos[None, None, :, None]
        s = jnp.einsum('bgrqd,bgqkd->bgrqk', q_blk, kg) * scale
        p = masked_softmax(s, mask[:, :, None])
        return jnp.einsum('bgrqk,bgqkd->bgrqd', p.astype(vg.dtype), vg)

    n_qs = S // SLC_Q_BLOCK
    o_slc = from_blocks(lax.map(slc_block, (to_blocks(qh, 3, SLC_Q_BLOCK), to_blocks(sel, 2, SLC_Q_BLOCK),
                                            jnp.arange(n_qs) * SLC_Q_BLOCK)), 3)

    kw_pad = jnp.pad(k_w, ((0, 0), (0, 0), (WINDOW, 0), (0, 0)))
    vw_pad = jnp.pad(v_w, ((0, 0), (0, 0), (WINDOW, 0), (0, 0)))
    span = Q_BLOCK + WINDOW

    def win_block(args):
        q_blk, q0 = args
        kb = lax.dynamic_slice_in_dim(kw_pad, q0, span, axis=2)
        vb = lax.dynamic_slice_in_dim(vw_pad, q0, span, axis=2)
        key_pos = q0 - WINDOW + jnp.arange(span)
        q_pos = q0 + jnp.arange(Q_BLOCK)
        d = q_pos[:, None] - key_pos[None, :]
        mask = (d >= 0) & (d < WINDOW) & (key_pos[None, :] >= 0)
        s = jnp.einsum('bgrqd,bgkd->bgrqk', q_blk, kb) * scale
        p = masked_softmax(s, mask)
        return jnp.einsum('bgrqk,bgkd->bgrqd', p.astype(vb.dtype), vb)

    n_q = S // Q_BLOCK
    o_win = from_blocks(lax.map(win_block, (to_blocks(qh, 3, Q_BLOCK), jnp.arange(n_q) * Q_BLOCK)), 3)

    g = jax.nn.sigmoid(gates.astype(jnp.float32)).reshape(B, S, G, R, 3).transpose(0, 2, 3, 1, 4)
    o = g[..., 0:1] * o_cmp + g[..., 1:2] * o_slc + g[..., 2:3] * o_win
    return o.transpose(0, 3, 1, 2, 4).reshape(B, S, NSA_Q).astype(q.dtype)


def pool_mixer(u, pool_w, pool_scale):
    B, S, _ = u.shape
    uf = u.astype(jnp.float32).reshape(B, S, POOL_GROUPS, POOL_GROUP_DIM)
    csum = jnp.cumsum(uf, axis=1)
    t1 = jnp.arange(1, S + 1, dtype=jnp.float32)
    means = []
    for gi, w in enumerate(POOL_WINDOWS):
        c = csum[:, :, gi]
        lagged = jnp.pad(c[:, :S - w], ((0, 0), (w, 0), (0, 0)))
        means.append((c - lagged) / jnp.minimum(t1, float(w))[None, :, None])
    pooled = jnp.stack(means, axis=2) - uf
    y = jnp.einsum('bsgc,gcd->bsgd', pooled.astype(u.dtype), pool_w)
    return y.reshape(B, S, POOL_WIDTH) * pool_scale


def fox_mixer(qkv, f_logit, b_f):
    B, S, _ = qkv.shape
    scale = HEAD_DIM ** -0.5
    q, k, v = [a.reshape(B, S, FOX_HEADS, HEAD_DIM).transpose(0, 2, 1, 3) for a in jnp.split(qkv, 3, axis=-1)]
    log_f = jax.nn.log_sigmoid(f_logit.astype(jnp.float32) + b_f.astype(jnp.float32))
    cum = jnp.cumsum(log_f, axis=1).transpose(0, 2, 1)
    key_pos = jnp.arange(S)

    def blk(args):
        q_blk, c_blk, q0 = args
        s = (jnp.einsum('bhqd,bhkd->bhqk', q_blk, k).astype(jnp.float32) * scale
             + c_blk[..., None] - cum[:, :, None, :])
        mask = key_pos[None, :] <= (q0 + jnp.arange(Q_BLOCK))[:, None]
        p = masked_softmax(s, mask)
        return jnp.einsum('bhqk,bhkd->bhqd', p.astype(v.dtype), v)

    n_q = S // Q_BLOCK
    o = from_blocks(lax.map(blk, (to_blocks(q, 2, Q_BLOCK), to_blocks(cum, 2, Q_BLOCK),
                                  jnp.arange(n_q) * Q_BLOCK)), 2)
    return o.transpose(0, 2, 1, 3).reshape(B, S, FOX_W)


def swiglu(h, wg, wu, wd):
    return (jax.nn.silu(h @ wg) * (h @ wu)) @ wd


def moe_ffn(h, router, wg, wu, wd):
    B, S, D = h.shape
    hf = h.reshape(B * S, D)
    logits = (hf @ router).astype(jnp.float32)
    top_val, top_idx = lax.top_k(logits, TOP_K)
    top_w = jax.nn.softmax(top_val, axis=-1)
    out = jnp.zeros(hf.shape, jnp.float32)
    for e in range(N_EXPERTS):
        gate_e = jnp.sum(jnp.where(top_idx == e, top_w, 0.0), axis=-1)
        out = out + gate_e[:, None] * swiglu(hf, wg[e], wu[e], wd[e]).astype(jnp.float32)
    return out.astype(h.dtype).reshape(B, S, D)


def setup_inputs(seed: int = 0) -> dict:
    key = jax.random.key(seed)
    ks = jax.random.split(key, 20)
    f32 = jnp.float32

    def normal(k, shape, fan_in):
        return jax.random.normal(k, shape, f32) * (fan_in ** -0.5)

    def gain(k, shape):
        return 1.0 + 0.05 * jax.random.normal(k, shape, f32)

    return {
        'x': jax.random.normal(ks[0], (BATCH, SEQ, D_MODEL), f32),
        'norm1': gain(ks[1], (DEPTH, D_MODEL)),
        'w_in': normal(ks[2], (DEPTH, D_MODEL, D_IN), D_MODEL),
        'cmp_pe': 0.1 * jax.random.normal(ks[3], (DEPTH, 2, CMP_BLOCK, HEAD_DIM), f32),
        'cmp_w1': normal(ks[4], (DEPTH, 2, CMP_BLOCK * HEAD_DIM, HEAD_DIM), CMP_BLOCK * HEAD_DIM),
        'cmp_w2': normal(ks[5], (DEPTH, 2, HEAD_DIM, HEAD_DIM), HEAD_DIM),
        'pool_w': normal(ks[6], (DEPTH, POOL_GROUPS, POOL_GROUP_DIM, POOL_GROUP_DIM), POOL_GROUP_DIM),
        'pool_scale': gain(ks[7], (DEPTH, POOL_WIDTH)),
        'fox_fbias': jax.random.uniform(ks[8], (DEPTH, FOX_HEADS), f32, minval=1.0, maxval=4.0),
        'mix_gain': gain(ks[9], (DEPTH, D_MIX)),
        'w_out': normal(ks[10], (DEPTH, D_MIX, D_MODEL), D_MIX),
        'norm2': gain(ks[11], (DEPTH, D_MODEL)),
        'ffn_wg': normal(ks[12], (N_DENSE, D_MODEL, D_FF), D_MODEL),
        'ffn_wu': normal(ks[13], (N_DENSE, D_MODEL, D_FF), D_MODEL),
        'ffn_wd': normal(ks[14], (N_DENSE, D_FF, D_MODEL), D_FF),
        'moe_router': normal(ks[15], (N_MOE, D_MODEL, N_EXPERTS), D_MODEL),
        'moe_wg': normal(ks[16], (N_MOE, N_EXPERTS, D_MODEL, D_FF_EXPERT), D_MODEL),
        'moe_wu': normal(ks[17], (N_MOE, N_EXPERTS, D_MODEL, D_FF_EXPERT), D_MODEL),
        'moe_wd': normal(ks[18], (N_MOE, N_EXPERTS, D_FF_EXPERT, D_MODEL), D_FF_EXPERT),
        'final_norm': gain(ks[19], (D_MODEL,)),
    }


def reference(x, norm1, w_in, cmp_pe, cmp_w1, cmp_w2, pool_w, pool_scale, fox_fbias, mix_gain, w_out,
              norm2, ffn_wg, ffn_wu, ffn_wd, moe_router, moe_wg, moe_wu, moe_wd, final_norm):
    for l in range(DEPTH):
        h = rms_norm(x, norm1[l])
        proj = h @ w_in[l]
        q_nsa, kv_nsa, g_nsa, u_pool, qkv_fox, f_fox = jnp.split(proj, SPLIT_POINTS, axis=-1)
        a = nsa_mixer(q_nsa, kv_nsa, g_nsa, cmp_pe[l], cmp_w1[l], cmp_w2[l])
        p = pool_mixer(u_pool, pool_w[l], pool_scale[l])
        c = fox_mixer(qkv_fox, f_fox, fox_fbias[l])
        g_a, g_p, g_c = jnp.split(mix_gain[l], [NSA_Q, NSA_Q + POOL_WIDTH])
        mixed = jnp.concatenate([rms_norm(a, g_a), rms_norm(p, g_p), rms_norm(c, g_c)], axis=-1)
        x = x + (mixed @ w_out[l]).astype(x.dtype)
        h = rms_norm(x, norm2[l])
        i = l // 2
        if l % 2 == 0:
            x = x + swiglu(h, ffn_wg[i], ffn_wu[i], ffn_wd[i]).astype(x.dtype)
        else:
            x = x + moe_ffn(h, moe_router[i], moe_wg[i], moe_wu[i], moe_wd[i]).astype(x.dtype)
    return rms_norm(x, final_norm)
```

```cpp
#include <hip/hip_runtime.h>
#include <stdint.h>
#include <cstdio>

#ifndef INPROJ_FP8
#define INPROJ_FP8 1
#endif
#ifndef REF0
#define REF0 0.f
#endif
#ifndef PHM
#define PHM 0xFFFF
#endif
#ifndef REPM
#define REPM 0
#endif
#ifndef WGM_INPROJ
#define WGM_INPROJ 4
#endif
#ifndef WGM_OUT
#define WGM_OUT 4
#endif
#ifndef WGM_FUP
#define WGM_FUP 8
#endif
#ifndef WGM_FDOWN
#define WGM_FDOWN 4
#endif
#ifndef WGM_MUP
#define WGM_MUP 8
#endif
#ifndef WGM_MDOWN
#define WGM_MDOWN 4
#endif
#ifndef MK_PER_PHASE
#define MK_PER_PHASE 0
#endif

#define LAS __attribute__((address_space(3)))
typedef unsigned short bf16_t;
typedef short bf16x8 __attribute__((ext_vector_type(8)));
typedef short s16x4 __attribute__((ext_vector_type(4)));
typedef float f32x2 __attribute__((ext_vector_type(2)));
typedef float f32x4 __attribute__((ext_vector_type(4)));
typedef float f32x16 __attribute__((ext_vector_type(16)));
typedef unsigned u32x2 __attribute__((ext_vector_type(2)));
typedef unsigned u32x4 __attribute__((ext_vector_type(4)));

__device__ __forceinline__ int otid() { int t = threadIdx.x; asm volatile("" : "+v"(t)); return t; }

__device__ __forceinline__ int obid() { int b = blockIdx.x; asm volatile("" : "+s"(b)); return b; }

constexpr int DM = 2048, NB = 4, SEQ = 4096, NT = NB * SEQ, DEPTH = 4;
constexpr int NPROJ = 4864;
constexpr int DFF = 5632, DFE = 3584, NEXP = 8;
constexpr int MOE_MAXT = 136;
constexpr int PC_Q = 0, PC_KC = 1024, PC_VC = 1280, PC_KS = 1536, PC_VS = 1792, PC_KW = 2048, PC_VW = 2304, PC_POOL = 2560, PC_FQ = 3072, PC_FK = 3584, PC_FV = 4096;
constexpr float LOG2E = 1.4426950408889634f;
constexpr float QK_C2 = 0.08838834764831845f * 1.4426950408889634f;

constexpr size_t al256(size_t x) { return (x + 255) & ~(size_t)255; }
constexpr size_t WS_CTL = 0;
constexpr size_t CTL_BYTES = 65536;
constexpr size_t WS_X = CTL_BYTES;
constexpr size_t WS_H = WS_X + (size_t)NT * DM * 4;
constexpr size_t WS_PROJ = WS_H + (size_t)NT * DM * 2;
constexpr size_t WS_MIX = WS_PROJ + (size_t)NT * NPROJ * 2;
constexpr size_t WS_ACT = WS_MIX + (size_t)MOE_MAXT * 256 * DM * 2;
constexpr size_t WS_GF = WS_ACT + (size_t)MOE_MAXT * 256 * DFE * 2;
constexpr size_t WS_CUM = WS_GF + (size_t)NT * 32 * 4;
constexpr size_t WS_KC = WS_CUM + (size_t)16 * SEQ * 4;
constexpr size_t WS_ROUTE = WS_KC + (size_t)2 * 8 * 256 * 128 * 2;
constexpr size_t WS_HIST = WS_ROUTE + (size_t)NT * 8 * 4;
constexpr size_t WS_TAB = WS_HIST + 256 * 8 * 4;
constexpr size_t WS_B1 = WS_TAB + 256;
constexpr size_t WS_ILIST = WS_B1 + 8 * 128 * 4;
constexpr size_t WS_ROWTOK = WS_ILIST + 4096;
constexpr size_t WS_KSG = WS_ROWTOK + (size_t)MOE_MAXT * 256 * 4;
constexpr size_t WS_WIN = WS_KSG + 4096;
constexpr size_t WS_WOUT = WS_WIN + (size_t)DEPTH * NPROJ * DM * 2;
constexpr size_t WS_WFGU = WS_WOUT + (size_t)DEPTH * DM * DM * 2;
constexpr size_t WS_WFD = WS_WFGU + (size_t)2 * 2 * DFF * DM * 2;
constexpr size_t WS_WMGU = WS_WFD + (size_t)2 * DM * DFF * 2;
constexpr size_t WS_WMD = WS_WMGU + (size_t)16 * 2 * DFE * DM * 2;
constexpr size_t WS_WC1 = WS_WMD + (size_t)16 * DM * DFE * 2;
constexpr size_t WS_WC2 = WS_WC1 + (size_t)8 * 128 * 4096 * 2;
constexpr size_t WS_WPOOL = WS_WC2 + (size_t)8 * 128 * 128 * 2;
constexpr size_t WS_END = WS_WPOOL + (size_t)16 * 128 * 128 * 2;
static_assert((size_t)NT * DM * 4 <= (size_t)MOE_MAXT * 256 * DM * 2, "mixraw fits");
static_assert((size_t)NT * DFF * 2 <= (size_t)MOE_MAXT * 256 * DFE * 2, "act fits");
static_assert((size_t)MOE_MAXT * 256 * DM * 2 <= (size_t)NT * NPROJ * 2, "Hg fits");

#define XB_TMO      128
#define XB_XCNT(j)  (256  + 64 * (j))
#define XB_XSUB(j)  (1280 + 64 * (j))
#define XB_XGEN(j)  (2304 + 64 * (j))
#define XB_TOP      3328
#define XB_TOPGEN   3392
#define XCD_BAR_WORDS 3456
#define XB_SPIN_CAP (1u << 18)

__device__ __forceinline__ unsigned xb_ld(unsigned* p)              { return __hip_atomic_load(p, __ATOMIC_RELAXED, __HIP_MEMORY_SCOPE_AGENT); }
__device__ __forceinline__ unsigned xb_add(unsigned* p, unsigned v) { return __hip_atomic_fetch_add(p, v, __ATOMIC_RELAXED, __HIP_MEMORY_SCOPE_AGENT); }
__device__ __forceinline__ unsigned xb_xcc_id() { return (unsigned)__builtin_amdgcn_s_getreg((3 << 11) | 20) & 0xFu; }
#define XB_SPIN(cond, bar) do { unsigned _sp = 0; while (cond) { __builtin_amdgcn_s_sleep(1); \
    if ((++_sp & 255u) == 0u) { if (xb_ld(&(bar)[XB_TMO])) break; if (_sp > XB_SPIN_CAP) { atomicAdd(&(bar)[XB_TMO], 1u); break; } } } } while (0)

struct XcdBarrier { unsigned* bar; unsigned x; volatile LAS unsigned* st; };

__device__ __forceinline__ XcdBarrier xcd_barrier_post(unsigned* bar, volatile LAS unsigned* st) {
    XcdBarrier b; b.bar = bar; b.x = xb_xcc_id(); b.st = st;
    if (threadIdx.x == 0) (void)xb_add(&bar[XB_XCNT(b.x)], 1u);
    return b;
}
__device__ __forceinline__ void xcd_barrier_complete(unsigned* bar, unsigned x, unsigned& nloc, unsigned& nx) {
    const unsigned G = gridDim.x * gridDim.y * gridDim.z;
    unsigned sum, cnt, mine, sp = 0u;
    for (;;) {
        sum = 0u; cnt = 0u; mine = 0u;
#pragma unroll
        for (unsigned j = 0; j < 16; ++j) { const unsigned c = xb_ld(&bar[XB_XCNT(j)]); sum += c; cnt += (c > 0u) ? 1u : 0u; mine = (j == x) ? c : mine; }
        if (sum == G) break;
        __builtin_amdgcn_s_sleep(1);
        if ((++sp & 255u) == 0u) { if (xb_ld(&bar[XB_TMO])) break; if (sp > XB_SPIN_CAP) { atomicAdd(&bar[XB_TMO], 1u); break; } }
    }
    nloc = mine > 0u ? mine : 1u; nx = cnt > 0u ? cnt : 1u;
}
__device__ __forceinline__ void xcd_barrier(const XcdBarrier& b) {
    asm volatile("s_waitcnt vmcnt(0)" ::: "memory");
    __syncthreads();
    if (threadIdx.x == 0) {
        unsigned* bar = b.bar;
        __builtin_amdgcn_s_waitcnt(0);
        unsigned nloc = b.st[0], nx = b.st[1];
        if (nloc == 0u) { xcd_barrier_complete(bar, b.x, nloc, nx); b.st[0] = nloc; b.st[1] = nx; }
        const unsigned old = xb_add(&bar[XB_XSUB(b.x)], 1u);
        const unsigned gen = old / nloc;
        if (old + 1u == (gen + 1u) * nloc) {
            __builtin_amdgcn_fence(__ATOMIC_RELEASE, "agent");
            asm volatile("s_waitcnt vmcnt(0)" ::: "memory");
            const unsigned og = xb_add(&bar[XB_TOP], 1u);
            const unsigned tg = og / nx;
            if (og + 1u == (tg + 1u) * nx) xb_add(&bar[XB_TOPGEN], 1u);
            else XB_SPIN(xb_ld(&bar[XB_TOPGEN]) == tg, bar);
            __builtin_amdgcn_fence(__ATOMIC_ACQUIRE, "agent");
            xb_add(&bar[XB_XGEN(b.x)], 1u);
            asm volatile("s_waitcnt vmcnt(0)" ::: "memory");
        } else {
            XB_SPIN(xb_ld(&bar[XB_XGEN(b.x)]) == gen, bar);
            __builtin_amdgcn_fence(__ATOMIC_ACQUIRE, "agent");
            asm volatile("s_waitcnt vmcnt(0)" ::: "memory");
        }
    }
    __syncthreads();
}

namespace pg8 {
constexpr int BM = 256, BK = 64, HALF = 128, HTB = HALF * BK * 2, STAGE_BYTES = 8 * HTB, NXCD = 8;
__host__ __device__ __forceinline__ int lds_byte(int r, int c) { const int st = (r >> 4) * 2 + (c >> 5), rr = r & 15, cc = c & 31, ob = rr * 64 + cc * 2; return st * 1024 + (ob ^ (((ob >> 9) & 1) << 5)); }
__host__ __device__ __forceinline__ void stage_rc(int b, int& R, int& C) { const int st = b / 1024, sb = b % 1024, swz = sb ^ (((sb >> 9) & 1) << 5); R = (st >> 1) * 16 + swz / 64; C = (st & 1) * 32 + (swz % 64) / 2; }
__host__ __device__ __forceinline__ int perm32(int rho) { const int n = rho >> 4, i = rho & 15; return 8 * (i >> 2) + 4 * n + (i & 3); }

struct Unit { int pm, pn; };
struct Gemm { const bf16_t* A; const bf16_t* Bt; int M, N, K; const int* rowmap; };

struct StaticOrder {
    int nM, nN, nwg, G, c, WGM;
    __device__ void init(int M, int N, int G_, int c_, int wgm = 4) { nM = M / BM; nN = N / BM; nwg = nM * nN; G = G_; c = c_; WGM = wgm; }
    __device__ bool next(int i, Unit& u) const {
        const long L = (long)i * G + c; if (L >= nwg) return false;
        int wgid = (int)L; { const int q = nwg / NXCD, r = nwg % NXCD, xcd = wgid % NXCD, off = wgid / NXCD; wgid = (xcd < r ? xcd * (q + 1) : r * (q + 1) + (xcd - r) * q) + off; }
        const int nig = WGM * nN, gid = wgid / nig, fm = gid * WGM, gsz = (nM - fm) < WGM ? (nM - fm) : WGM;
        u.pm = fm + ((wgid % nig) % gsz); u.pn = (wgid % nig) / gsz; return true;
    }
    __device__ __forceinline__ int btile(const Unit& u) const { return u.pn; }
};
struct GroupedOrder : StaticOrder {
    int t1, t2, t3, t4, t5, t6, t7;
    __device__ void initg(const int* toff, int N, int G_, int c_, int wgm = 4) { t1 = toff[1]; t2 = toff[2]; t3 = toff[3]; t4 = toff[4]; t5 = toff[5]; t6 = toff[6]; t7 = toff[7]; init(toff[8] * BM, N, G_, c_, wgm); }
    __device__ __forceinline__ int btile(const Unit& u) const {
        const int p = u.pm; const int e = (p >= t1) + (p >= t2) + (p >= t3) + (p >= t4) + (p >= t5) + (p >= t6) + (p >= t7);
        return e * nN + u.pn; }
};

__device__ __forceinline__ unsigned cvt_pk_bf16(float lo, float hi) { unsigned r; asm volatile("v_cvt_pk_bf16_f32 %0, %1, %2" : "=v"(r) : "v"(lo), "v"(hi)); return r; }


template <class Epi, class Sched, bool GATHER = false, bool FP8 = false>
__device__ __forceinline__ void gemm_phase(LAS unsigned char* lds, const Gemm g, const Sched& S, const Epi& E) {
    const int tid = otid(), wid = __builtin_amdgcn_readfirstlane(tid >> 6), lane = tid & 63, wr = wid >> 2, wc = wid & 3, fr = lane & 15, fq = lane >> 4;
    const int K = g.K, nt = K / BK;
    unsigned voffA[2], voffB[2];
#pragma unroll
    for (int i = 0; i < 2; ++i) { int R, C; stage_rc(tid * 16 + i * 8192, R, C); const int Rb = Epi::PERM ? ((R & ~31) + perm32(R & 31)) : R;
        voffA[i] = (unsigned)(R * K + C) * 2u; voffB[i] = (unsigned)(Rb * K + C) * 2u; }
    const size_t kstep = (size_t)(BK * 2);
    const size_t hstep = (size_t)HALF * K * 2;
    const size_t tstep = 2 * hstep;
    const unsigned ldsw = (unsigned)wid * 1024u;
    const int aoff = lds_byte(wr * 64 + fr, fq * 8), boff = lds_byte(wc * 32 + fr, fq * 8);
#define PG8_SA(b, h) (((b) * 2 + (h)) * HTB)
#define PG8_SB(b, h) ((4 + (b) * 2 + (h)) * HTB)
#define PG8_STAGE(bufoff, gbase, voff) do { _Pragma("unroll") for (int _i = 0; _i < 2; ++_i) \
        __builtin_amdgcn_global_load_lds((const unsigned*)((const char*)(gbase) + (voff)[_i]), (LAS unsigned*)(lds + (bufoff) + ldsw + _i * 8192), 16, 0, 0); } while (0)
#define PG8_STAGE_A(bufoff, kb, h, nx) do { if constexpr (GATHER) { const char* gb_ = (const char*)g.A + (kb); \
        _Pragma("unroll") for (int _i = 0; _i < 2; ++_i) { const unsigned o_ = (nx) ? gN[h][_i] : gA[h][_i]; \
            __builtin_amdgcn_global_load_lds((const unsigned*)(gb_ + o_), (LAS unsigned*)(lds + (bufoff) + ldsw + _i * 8192), 16, 0, 0); } } \
    else { PG8_STAGE(bufoff, ((nx) ? nA : cA) + (kb) + (h) * hstep, voffA); } } while (0)
#define PG8_LDA(dst, b, h) do { if constexpr (FP8) { _Pragma("unroll") for (int m = 0; m < 4; ++m) { const v4i_ lo_ = *(const LAS v4i_*)(lds + PG8_SA(b, h) + aoff + m * 2048), hi_ = *(const LAS v4i_*)(lds + PG8_SA(b, h) + aoff + m * 2048 + 1024); \
            dst##8[m] = __builtin_shufflevector(lo_, hi_, 0, 1, 2, 3, 4, 5, 6, 7); } } \
        else { _Pragma("unroll") for (int m = 0; m < 4; ++m) _Pragma("unroll") for (int k = 0; k < 2; ++k) dst[m][k] = *(const LAS bf16x8*)(lds + PG8_SA(b, h) + aoff + m * 2048 + k * 1024); } } while (0)
#define PG8_LDB(dst, b, h) do { if constexpr (FP8) { _Pragma("unroll") for (int n = 0; n < 2; ++n) { const v4i_ lo_ = *(const LAS v4i_*)(lds + PG8_SB(b, h) + boff + n * 2048), hi_ = *(const LAS v4i_*)(lds + PG8_SB(b, h) + boff + n * 2048 + 1024); \
            dst##8[n] = __builtin_shufflevector(lo_, hi_, 0, 1, 2, 3, 4, 5, 6, 7); } } \
        else { _Pragma("unroll") for (int n = 0; n < 2; ++n) _Pragma("unroll") for (int k = 0; k < 2; ++k) dst[n][k] = *(const LAS bf16x8*)(lds + PG8_SB(b, h) + boff + n * 2048 + k * 1024); } } while (0)
#define PG8_MMA(ai, bj, At, Bt) do { __builtin_amdgcn_s_setprio(1); _Pragma("unroll") for (int m = 0; m < 4; ++m) _Pragma("unroll") for (int n = 0; n < 2; ++n) { \
        if constexpr (FP8) asm volatile("v_mfma_scale_f32_16x16x128_f8f6f4 %0, %1, %2, %0, %3, %3 op_sel_hi:[0,0,0]" : "+v"(acc[ai][bj][m][n]) : "v"(Bt##8[n]), "v"(At##8[m]), "v"(sc8_));   \
        else { _Pragma("unroll") for (int k = 0; k < 2; ++k) acc[ai][bj][m][n] = __builtin_amdgcn_mfma_f32_16x16x32_bf16(Bt[n][k], At[m][k], acc[ai][bj][m][n], 0, 0, 0); } } \
        __builtin_amdgcn_s_setprio(0); } while (0)
#define PG8_WAIT_V(n) asm volatile("s_waitcnt vmcnt(" #n ")" ::: "memory")
#define PG8_WAIT_L(n) asm volatile("s_waitcnt lgkmcnt(" #n ")" ::: "memory")
#define PG8_BAR __builtin_amdgcn_s_barrier()
#define PG8_SCHED __builtin_amdgcn_sched_barrier(0)
    Unit cur, nxt; int ui = 0;
    if (!S.next(0, cur)) return;
    f32x4 acc[2][2][4][2];
#pragma unroll
    for (int a = 0; a < 2; ++a)
#pragma unroll
        for (int b = 0; b < 2; ++b)
#pragma unroll
            for (int m = 0; m < 4; ++m)
#pragma unroll
                for (int n = 0; n < 2; ++n) acc[a][b][m][n] = (f32x4){0.f, 0.f, 0.f, 0.f};
    typedef int v8i_ __attribute__((ext_vector_type(8))); typedef int v4i_ __attribute__((ext_vector_type(4)));
    bf16x8 At[4][2], B0[2][2], B1[2][2];
    v8i_ At8[4], B08[2], B18[2];
    const int sc8_ = 0x7F7F7F7F;
    const char* cA = (const char*)g.A + (GATHER ? (size_t)0 : (size_t)cur.pm * tstep); const char* cB = (const char*)g.Bt + (size_t)S.btile(cur) * tstep;
    const char* nA = cA;
    unsigned gA[2][2], gN[2][2];
    if constexpr (GATHER) {
#pragma unroll
        for (int h = 0; h < 2; ++h)
#pragma unroll
            for (int i = 0; i < 2; ++i) { int R, C; stage_rc(tid * 16 + i * 8192, R, C); const int tok = g.rowmap[cur.pm * BM + h * HALF + R]; gA[h][i] = (unsigned)(tok * K + C) * 2u; gN[h][i] = gA[h][i]; }
    }
    PG8_STAGE(PG8_SB(0, 0), cB, voffB); PG8_STAGE_A(PG8_SA(0, 0), (size_t)0, 0, false); PG8_STAGE(PG8_SB(0, 1), cB + hstep, voffB); PG8_STAGE_A(PG8_SA(0, 1), (size_t)0, 1, false);
    if (wr == 1) PG8_BAR;
    PG8_WAIT_V(4); PG8_BAR;
    PG8_STAGE(PG8_SB(1, 0), cB + kstep, voffB); PG8_STAGE_A(PG8_SA(1, 0), kstep, 0, false); PG8_STAGE(PG8_SB(1, 1), cB + hstep + kstep, voffB);
    PG8_WAIT_V(6); PG8_BAR;
    for (;;) {
        const bool has_next = S.next(ui + 1, nxt);
        nA = (has_next && !GATHER) ? (const char*)g.A + (size_t)nxt.pm * tstep : cA; const char* nB = has_next ? (const char*)g.Bt + (size_t)S.btile(nxt) * tstep : cB;
        if constexpr (GATHER) { if (has_next && nxt.pm != cur.pm) {
#pragma unroll
            for (int h = 0; h < 2; ++h)
#pragma unroll
                for (int i = 0; i < 2; ++i) { int R, C; stage_rc(tid * 16 + i * 8192, R, C); const int tok = g.rowmap[nxt.pm * BM + h * HALF + R]; gN[h][i] = (unsigned)(tok * K + C) * 2u; } } }
        for (int t = 0; t < nt; t += 2) {
            const bool last = (t == nt - 2);
            const size_t k1 = (size_t)(t + 1) * kstep, k2 = last ? (size_t)0 : (size_t)(t + 2) * kstep, k3 = k2 + kstep;
            const char* b2 = last ? nB : cB + (size_t)(t + 2) * kstep;
            const char* b3 = b2 + kstep;
            PG8_LDB(B0, 0, 0); PG8_SCHED; PG8_LDA(At, 0, 0); PG8_STAGE_A(PG8_SA(1, 1), k1, 1, false);
            PG8_WAIT_L(8); PG8_BAR; PG8_WAIT_L(0); PG8_MMA(0, 0, At, B0); PG8_BAR; PG8_SCHED;
            PG8_LDB(B1, 0, 1); PG8_STAGE(PG8_SB(0, 0), b2, voffB);
            PG8_BAR; PG8_WAIT_L(0); PG8_MMA(0, 1, At, B1); PG8_BAR;
            PG8_LDA(At, 0, 1); PG8_STAGE_A(PG8_SA(0, 0), k2, 0, last);
            PG8_BAR; PG8_WAIT_L(0); PG8_MMA(1, 0, At, B0); PG8_BAR; PG8_SCHED;
            PG8_STAGE(PG8_SB(0, 1), b2 + hstep, voffB);
            PG8_WAIT_V(6); PG8_BAR; PG8_MMA(1, 1, At, B1); PG8_BAR;
            PG8_LDB(B0, 1, 0); PG8_SCHED; PG8_LDA(At, 1, 0); PG8_STAGE_A(PG8_SA(0, 1), k2, 1, last);
            PG8_WAIT_L(8); PG8_BAR; PG8_WAIT_L(0); PG8_MMA(0, 0, At, B0); PG8_BAR; PG8_SCHED;
            PG8_LDB(B1, 1, 1); PG8_STAGE(PG8_SB(1, 0), b3, voffB);
            PG8_BAR; PG8_WAIT_L(0); PG8_MMA(0, 1, At, B1); PG8_BAR;
            PG8_LDA(At, 1, 1); PG8_STAGE_A(PG8_SA(1, 0), k3, 0, last);
            PG8_BAR; PG8_WAIT_L(0); PG8_MMA(1, 0, At, B0); PG8_BAR; PG8_SCHED;
            PG8_STAGE(PG8_SB(1, 1), b3 + hstep, voffB);
            PG8_WAIT_V(6); PG8_BAR; PG8_MMA(1, 1, At, B1); PG8_BAR;
        }
        E(acc, cur, wr, wc, fr, fq);
        if (!has_next) break;
#pragma unroll
        for (int a = 0; a < 2; ++a)
#pragma unroll
            for (int b = 0; b < 2; ++b)
#pragma unroll
                for (int m = 0; m < 4; ++m)
#pragma unroll
                    for (int n = 0; n < 2; ++n) acc[a][b][m][n] = (f32x4){0.f, 0.f, 0.f, 0.f};
        cur = nxt; cA = nA; cB = nB; ++ui;
        if constexpr (GATHER) {
#pragma unroll
            for (int h = 0; h < 2; ++h)
#pragma unroll
                for (int i = 0; i < 2; ++i) gA[h][i] = gN[h][i]; }
    }
    PG8_WAIT_V(0);
    if (wr == 0) PG8_BAR;
    PG8_BAR;
#undef PG8_SA
#undef PG8_SB
#undef PG8_STAGE
#undef PG8_STAGE_A
#undef PG8_LDA
#undef PG8_LDB
#undef PG8_MMA
#undef PG8_WAIT_V
#undef PG8_WAIT_L
#undef PG8_BAR
#undef PG8_SCHED
}

struct EpiProj {
    static constexpr bool PERM = true;
    bf16_t* O; float* GF; float sc;
    __device__ __forceinline__ void operator()(const f32x4 (&acc)[2][2][4][2], const Unit& u, int wr, int wc, int fr, int fq) const {
        const int row0 = u.pm * BM + wr * 64 + fr; const float sc = (u.pn < 4 || u.pn == 12 || u.pn == 13) ? this->sc * QK_C2 : this->sc;
        if (u.pn < 18) {
            const int col0 = u.pn * BM + wc * 32 + 8 * fq;
#pragma unroll
            for (int ai = 0; ai < 2; ++ai)
#pragma unroll
                for (int m = 0; m < 4; ++m) { bf16_t* rowp = O + (size_t)(row0 + ai * HALF + m * 16) * NPROJ + col0;
#pragma unroll
                    for (int bj = 0; bj < 2; ++bj) { const f32x4 v0 = acc[ai][bj][m][0] * sc, v1 = acc[ai][bj][m][1] * sc;
                        u32x4 w; w.x = cvt_pk_bf16(v0[0], v0[1]); w.y = cvt_pk_bf16(v0[2], v0[3]); w.z = cvt_pk_bf16(v1[0], v1[1]); w.w = cvt_pk_bf16(v1[2], v1[3]);
                        *(u32x4*)(rowp + bj * HALF) = w; } }
        } else if (wc == 0) {
#pragma unroll
            for (int ai = 0; ai < 2; ++ai)
#pragma unroll
                for (int m = 0; m < 4; ++m) { float* rowp = GF + (size_t)(row0 + ai * HALF + m * 16) * 32 + 8 * fq;
                    *(f32x4*)(rowp) = acc[ai][0][m][0] * sc; *(f32x4*)(rowp + 4) = acc[ai][0][m][1] * sc; }
        }
    }
};
struct EpiResF32 {
    static constexpr bool PERM = false;
    const float* res; float* out; float sc;
    __device__ __forceinline__ void operator()(const f32x4 (&acc)[2][2][4][2], const Unit& u, int wr, int wc, int fr, int fq) const {
        const int row0 = u.pm * BM + wr * 64 + fr, col0 = u.pn * BM + wc * 32 + 4 * fq;
        f32x4 rv[2][2][2][2];
#define ERF_LOAD(par, g_) do { const int ai_ = (g_) >> 1, mp_ = (g_) & 1; _Pragma("unroll") for (int mm = 0; mm < 2; ++mm) { const size_t off_ = (size_t)(row0 + ai_ * HALF + (mp_ * 2 + mm) * 16) * DM + col0; \
            _Pragma("unroll") for (int bj = 0; bj < 2; ++bj) _Pragma("unroll") for (int n = 0; n < 2; ++n) rv[par][mm][bj][n] = *(const f32x4*)(res + off_ + bj * HALF + n * 16); } } while (0)
#define ERF_STORE(par, g_) do { const int ai_ = (g_) >> 1, mp_ = (g_) & 1; _Pragma("unroll") for (int mm = 0; mm < 2; ++mm) { const size_t off_ = (size_t)(row0 + ai_ * HALF + (mp_ * 2 + mm) * 16) * DM + col0; \
            _Pragma("unroll") for (int bj = 0; bj < 2; ++bj) _Pragma("unroll") for (int n = 0; n < 2; ++n) *(f32x4*)(out + off_ + bj * HALF + n * 16) = rv[par][mm][bj][n] + acc[ai_][bj][mp_ * 2 + mm][n] * sc; } } while (0)
        ERF_LOAD(0, 0); asm volatile("" ::: "memory");
        ERF_LOAD(1, 1); asm volatile("" ::: "memory");
        ERF_STORE(0, 0); asm volatile("" ::: "memory");
        ERF_LOAD(0, 2); asm volatile("" ::: "memory");
        ERF_STORE(1, 1); asm volatile("" ::: "memory");
        ERF_LOAD(1, 3); asm volatile("" ::: "memory");
        ERF_STORE(0, 2); asm volatile("" ::: "memory");
        ERF_STORE(1, 3);
#undef ERF_LOAD
#undef ERF_STORE
    }
};
struct EpiResB {
    static constexpr bool PERM = true;
    const void* res; int res_f32; bf16_t* out; float sc;
    __device__ __forceinline__ void operator()(const f32x4 (&acc)[2][2][4][2], const Unit& u, int wr, int wc, int fr, int fq) const {
        const int row0 = u.pm * BM + wr * 64 + fr, col0 = u.pn * BM + wc * 32 + 8 * fq;
        if (res_f32) {
            const float* rf = (const float*)res;
#pragma unroll
            for (int ai = 0; ai < 2; ++ai)
#pragma unroll
                for (int mp = 0; mp < 2; ++mp) { f32x4 rv[2][2][2];
#pragma unroll
                    for (int mm = 0; mm < 2; ++mm) { const size_t off = (size_t)(row0 + ai * HALF + (mp * 2 + mm) * 16) * DM + col0;
#pragma unroll
                        for (int bj = 0; bj < 2; ++bj)
#pragma unroll
                            for (int n = 0; n < 2; ++n) rv[mm][bj][n] = *(const f32x4*)(rf + off + bj * HALF + n * 4); }
#pragma unroll
                    for (int mm = 0; mm < 2; ++mm) { const size_t off = (size_t)(row0 + ai * HALF + (mp * 2 + mm) * 16) * DM + col0;
#pragma unroll
                        for (int bj = 0; bj < 2; ++bj) { const f32x4 v0 = rv[mm][bj][0] + acc[ai][bj][mp * 2 + mm][0] * sc, v1 = rv[mm][bj][1] + acc[ai][bj][mp * 2 + mm][1] * sc;
                            u32x4 w; w.x = cvt_pk_bf16(v0[0], v0[1]); w.y = cvt_pk_bf16(v0[2], v0[3]); w.z = cvt_pk_bf16(v1[0], v1[1]); w.w = cvt_pk_bf16(v1[2], v1[3]);
                            *(u32x4*)(out + off + bj * HALF) = w; } }
                    asm volatile("" ::: "memory"); }
        } else {
            const bf16_t* rb = (const bf16_t*)res;
            u32x4 rv[2][4][2];
#define ERB_LOAD(par, ai_) do { _Pragma("unroll") for (int m = 0; m < 4; ++m) { const size_t off_ = (size_t)(row0 + (ai_) * HALF + m * 16) * DM + col0; \
            _Pragma("unroll") for (int bj = 0; bj < 2; ++bj) rv[par][m][bj] = *(const u32x4*)(rb + off_ + bj * HALF); } } while (0)
#define ERB_STORE(par, ai_) do { _Pragma("unroll") for (int m = 0; m < 4; ++m) { const size_t off_ = (size_t)(row0 + (ai_) * HALF + m * 16) * DM + col0; \
            _Pragma("unroll") for (int bj = 0; bj < 2; ++bj) { const u32x4 r_ = rv[par][m][bj]; const f32x4 a0_ = acc[ai_][bj][m][0] * sc, a1_ = acc[ai_][bj][m][1] * sc; u32x4 w; \
                w.x = cvt_pk_bf16(__uint_as_float(r_.x << 16) + a0_[0], __uint_as_float(r_.x & 0xffff0000u) + a0_[1]); w.y = cvt_pk_bf16(__uint_as_float(r_.y << 16) + a0_[2], __uint_as_float(r_.y & 0xffff0000u) + a0_[3]); \
                w.z = cvt_pk_bf16(__uint_as_float(r_.z << 16) + a1_[0], __uint_as_float(r_.z & 0xffff0000u) + a1_[1]); w.w = cvt_pk_bf16(__uint_as_float(r_.w << 16) + a1_[2], __uint_as_float(r_.w & 0xffff0000u) + a1_[3]); \
                *(u32x4*)(out + off_ + bj * HALF) = w; } } } while (0)
            ERB_LOAD(0, 0); asm volatile("" ::: "memory");
            ERB_LOAD(1, 1); asm volatile("" ::: "memory");
            ERB_STORE(0, 0); asm volatile("" ::: "memory");
            ERB_STORE(1, 1);
#undef ERB_LOAD
#undef ERB_STORE
        }
    }
};
struct EpiSwiglu {
    static constexpr bool PERM = true;
    bf16_t* O; int ldc;
    __device__ __forceinline__ void operator()(const f32x4 (&acc)[2][2][4][2], const Unit& u, int wr, int wc, int fr, int fq) const {
        const int row0 = u.pm * BM + wr * 64 + fr, col0 = u.pn * HALF + wc * 32 + 8 * fq;
#pragma unroll
        for (int ai = 0; ai < 2; ++ai)
#pragma unroll
            for (int m = 0; m < 4; ++m) { bf16_t* rowp = O + (size_t)(row0 + ai * HALF + m * 16) * ldc + col0;
                float a[8];
#pragma unroll
                for (int n = 0; n < 2; ++n)
#pragma unroll
                    for (int i = 0; i < 4; ++i) { const float gv = acc[ai][0][m][n][i], uv = acc[ai][1][m][n][i];
                        const float sg = gv * __builtin_amdgcn_rcpf(1.0f + __builtin_amdgcn_exp2f(-gv * LOG2E)); a[n * 4 + i] = sg * uv; }
                u32x4 w; w.x = cvt_pk_bf16(a[0], a[1]); w.y = cvt_pk_bf16(a[2], a[3]); w.z = cvt_pk_bf16(a[4], a[5]); w.w = cvt_pk_bf16(a[6], a[7]);
                *(u32x4*)rowp = w; }
    }
};
struct EpiBf16 {
    static constexpr bool PERM = true;
    bf16_t* O; int ldc;
    __device__ __forceinline__ void operator()(const f32x4 (&acc)[2][2][4][2], const Unit& u, int wr, int wc, int fr, int fq) const {
        const int row0 = u.pm * BM + wr * 64 + fr, col0 = u.pn * BM + wc * 32 + 8 * fq;
#pragma unroll
        for (int ai = 0; ai < 2; ++ai)
#pragma unroll
            for (int m = 0; m < 4; ++m) { bf16_t* rowp = O + (size_t)(row0 + ai * HALF + m * 16) * ldc + col0;
#pragma unroll
                for (int bj = 0; bj < 2; ++bj) { const f32x4 v0 = acc[ai][bj][m][0], v1 = acc[ai][bj][m][1];
                    u32x4 w; w.x = cvt_pk_bf16(v0[0], v0[1]); w.y = cvt_pk_bf16(v0[2], v0[3]); w.z = cvt_pk_bf16(v1[0], v1[1]); w.w = cvt_pk_bf16(v1[2], v1[3]);
                    *(u32x4*)(rowp + bj * HALF) = w; } }
    }
};
__device__ __forceinline__ unsigned pack_fp8x4(float a, float b, float c, float d) { unsigned w = 0; w = __builtin_amdgcn_cvt_pk_fp8_f32(a, b, w, false); w = __builtin_amdgcn_cvt_pk_fp8_f32(c, d, w, true); return w; }
struct EpiSwiglu8 {
    static constexpr bool PERM = true;
    unsigned char* O; int ldc; float sc;
    __device__ __forceinline__ void operator()(const f32x4 (&acc)[2][2][4][2], const Unit& u, int wr, int wc, int fr, int fq) const {
        const int row0 = u.pm * BM + wr * 64 + fr, col0 = u.pn * HALF + wc * 32 + 8 * fq;
#pragma unroll
        for (int ai = 0; ai < 2; ++ai)
#pragma unroll
            for (int m = 0; m < 4; ++m) { unsigned char* rowp = O + (size_t)(row0 + ai * HALF + m * 16) * ldc + col0;
                float a[8];
#pragma unroll
                for (int n = 0; n < 2; ++n)
#pragma unroll
                    for (int i = 0; i < 4; ++i) { const float gv = acc[ai][0][m][n][i] * sc, uv = acc[ai][1][m][n][i] * sc;
                        const float sg = gv * __builtin_amdgcn_rcpf(1.0f + __builtin_amdgcn_exp2f(-gv * LOG2E)); a[n * 4 + i] = sg * uv; }
                u32x2 w; w.x = pack_fp8x4(a[0], a[1], a[2], a[3]); w.y = pack_fp8x4(a[4], a[5], a[6], a[7]);
                *(u32x2*)rowp = w; }
    }
};
struct EpiFp8S {
    static constexpr bool PERM = true;
    unsigned char* O; int ldc; float sc;
    __device__ __forceinline__ void operator()(const f32x4 (&acc)[2][2][4][2], const Unit& u, int wr, int wc, int fr, int fq) const {
        const int row0 = u.pm * BM + wr * 64 + fr, col0 = u.pn * BM + wc * 32 + 8 * fq;
#pragma unroll
        for (int ai = 0; ai < 2; ++ai)
#pragma unroll
            for (int m = 0; m < 4; ++m) { unsigned char* rowp = O + (size_t)(row0 + ai * HALF + m * 16) * ldc + col0;
#pragma unroll
                for (int bj = 0; bj < 2; ++bj) { const f32x4 v0 = acc[ai][bj][m][0] * sc, v1 = acc[ai][bj][m][1] * sc;
                    u32x2 w; w.x = pack_fp8x4(v0[0], v0[1], v0[2], v0[3]); w.y = pack_fp8x4(v1[0], v1[1], v1[2], v1[3]);
                    *(u32x2*)(rowp + bj * HALF) = w; } }
    }
};
struct EpiBf16S {
    static constexpr bool PERM = true;
    bf16_t* O; int ldc; float sc;
    __device__ __forceinline__ void operator()(const f32x4 (&acc)[2][2][4][2], const Unit& u, int wr, int wc, int fr, int fq) const {
        const int row0 = u.pm * BM + wr * 64 + fr, col0 = u.pn * BM + wc * 32 + 8 * fq;
#pragma unroll
        for (int ai = 0; ai < 2; ++ai)
#pragma unroll
            for (int m = 0; m < 4; ++m) { bf16_t* rowp = O + (size_t)(row0 + ai * HALF + m * 16) * ldc + col0;
#pragma unroll
                for (int bj = 0; bj < 2; ++bj) { const f32x4 v0 = acc[ai][bj][m][0] * sc, v1 = acc[ai][bj][m][1] * sc;
                    u32x4 w; w.x = cvt_pk_bf16(v0[0], v0[1]); w.y = cvt_pk_bf16(v0[2], v0[3]); w.z = cvt_pk_bf16(v1[0], v1[1]); w.w = cvt_pk_bf16(v1[2], v1[3]);
                    *(u32x4*)(rowp + bj * HALF) = w; } }
    }
};
}

namespace at {
constexpr int SHM = 16384;
constexpr int OFF_V = 0, OFF_K = SHM  , OFF_WS = 4 * SHM, OFF_CK = 4 * SHM + 2048, OFF_IMP = 4 * SHM + 4096, OFF_MASK = OFF_IMP + 64 * 65 * 4, OFF_Q = OFF_MASK + 512, OFF_FOXB = OFF_Q + 64  , OFF_DEAD = OFF_FOXB + 512  , OFF_END = OFF_DEAD + 64;
static_assert(OFF_END <= 131072, "attention LDS map");
enum { M_WIN = 0, M_FOX = 1, M_SLC = 2, M_CMP = 3 };

#define KSWZ(row, colB) ((row) * 256 + ((colB) ^ (((row) & 7) << 4)))
#define SBAR() __builtin_amdgcn_sched_barrier(0)
#define BAR_LDS() do { asm volatile("s_waitcnt lgkmcnt(0)" ::: "memory"); __builtin_amdgcn_s_barrier(); asm volatile("" ::: "memory"); } while (0)
__device__ __forceinline__ int v_st(int k, int c) { const int kk = (k & ~0xC) | ((k & 4) << 1) | ((k & 8) >> 1); return ((kk >> 3) * 4 + (c >> 5)) * 512 + ((kk & 7) * 32 + (c & 31)) * 2; }
__device__ __forceinline__ int v_rd_base(int lane) { return ((lane & 3) << 3) | (((lane >> 2) & 3) << 6) | (((lane >> 4) & 1) << 5) | (((lane >> 5) & 1) << 8); }
constexpr int v_rd_off(int d0, int ks, int half) { return d0 * 512 + ks * 4096 + half * 2048; }
__device__ __forceinline__ int crow(int r, int hi) { return (r & 3) + 8 * (r >> 2) + 4 * hi; }
__device__ __forceinline__ unsigned cvtpk(float lo, float hi) { unsigned r; asm volatile("v_cvt_pk_bf16_f32 %0, %1, %2" : "=v"(r) : "v"(lo), "v"(hi)); return r; }

#ifndef QK_PF
#define QK_PF 2
#endif
__device__ __forceinline__ void qkt(f32x16& p0, f32x16& p1, LAS const char* K_lds, int r32, int hi, const bf16x8 (&qr)[8]) {
#pragma unroll
    for (int r = 0; r < 16; ++r) { p0[r] = 0.f; p1[r] = 0.f; }
    LAS const char* kb[4];
#pragma unroll
    for (int dd = 0; dd < 4; ++dd) kb[dd] = K_lds + KSWZ(r32, (dd * 16 + hi * 8) * 2);
    bf16x8 f0[QK_PF], f1[QK_PF];
#pragma unroll
    for (int d0 = 0; d0 < QK_PF; ++d0) { LAS const char* a = kb[d0 & 3] + (d0 >> 2) * 128; f0[d0] = *(LAS const bf16x8*)a; f1[d0] = *(LAS const bf16x8*)(a + 32 * 256); }
    SBAR();
#pragma unroll
    for (int d0 = 0; d0 < 8; ++d0) {
        p0 = __builtin_amdgcn_mfma_f32_32x32x16_bf16(f0[d0 % QK_PF], qr[d0], p0, 0, 0, 0);
        p1 = __builtin_amdgcn_mfma_f32_32x32x16_bf16(f1[d0 % QK_PF], qr[d0], p1, 0, 0, 0);
        if (d0 + QK_PF < 8) { LAS const char* a = kb[(d0 + QK_PF) & 3] + ((d0 + QK_PF) >> 2) * 128; f0[d0 % QK_PF] = *(LAS const bf16x8*)a; f1[d0 % QK_PF] = *(LAS const bf16x8*)(a + 32 * 256); }
        SBAR(); }
}
__device__ __forceinline__ void pv_tile(f32x16 (&o)[4], unsigned vb0, bf16x8 pa0, bf16x8 pa1, bf16x8 pa2, bf16x8 pa3) {
#define TRRD(dst, off) asm volatile("ds_read_b64_tr_b16 %0, %1 offset:%2" : "=&v"(dst) : "v"(vb0), "i"(off) : "memory")
#define PV_D0(d0) do { s16x4 l0, l1, l2, l3, h0, h1, h2, h3; constexpr int b_ = v_rd_off(d0, 0, 0); \
        TRRD(l0, b_); TRRD(h0, b_ + 2048); TRRD(l1, b_ + 4096); TRRD(h1, b_ + 6144); TRRD(l2, b_ + 8192); TRRD(h2, b_ + 10240); TRRD(l3, b_ + 12288); TRRD(h3, b_ + 14336); \
        asm volatile("s_waitcnt lgkmcnt(0)" ::: "memory"); SBAR(); \
        o[d0] = __builtin_amdgcn_mfma_f32_32x32x16_bf16(pa0, (bf16x8){l0[0], l0[1], l0[2], l0[3], h0[0], h0[1], h0[2], h0[3]}, o[d0], 0, 0, 0); \
        o[d0] = __builtin_amdgcn_mfma_f32_32x32x16_bf16(pa1, (bf16x8){l1[0], l1[1], l1[2], l1[3], h1[0], h1[1], h1[2], h1[3]}, o[d0], 0, 0, 0); \
        o[d0] = __builtin_amdgcn_mfma_f32_32x32x16_bf16(pa2, (bf16x8){l2[0], l2[1], l2[2], l2[3], h2[0], h2[1], h2[2], h2[3]}, o[d0], 0, 0, 0); \
        o[d0] = __builtin_amdgcn_mfma_f32_32x32x16_bf16(pa3, (bf16x8){l3[0], l3[1], l3[2], l3[3], h3[0], h3[1], h3[2], h3[3]}, o[d0], 0, 0, 0); } while (0)
    PV_D0(0); PV_D0(1); PV_D0(2); PV_D0(3);
#undef PV_D0
#undef TRRD
}
__device__ __forceinline__ void mask_range(f32x16& p0, f32x16& p1, int hi, int lo, int len) {
    const float NEG = -__builtin_inff(); const int b = 4 * hi - lo; const unsigned ul = (unsigned)(len < 0 ? 0 : len);
#pragma unroll
    for (int r = 0; r < 16; ++r) { const int c = (r & 3) + 8 * (r >> 2);
        if ((unsigned)(c + b) >= ul) p0[r] = NEG;
        if ((unsigned)(c + 32 + b) >= ul) p1[r] = NEG; }
}
__device__ __forceinline__ void pack_p(const f32x16& p0, const f32x16& p1, bf16x8& pa0, bf16x8& pa1, bf16x8& pa2, bf16x8& pa3) {
#define PK4(P, B_, OUT) do { unsigned a0 = cvtpk(P[B_+0], P[B_+1]), a1 = cvtpk(P[B_+2], P[B_+3]); \
        unsigned b0 = cvtpk(P[B_+4], P[B_+5]), b1 = cvtpk(P[B_+6], P[B_+7]); \
        auto r0 = __builtin_amdgcn_permlane32_swap(a0, b0, false, false); auto r1 = __builtin_amdgcn_permlane32_swap(a1, b1, false, false); \
        u32x4 w = {r0[0], r1[0], r0[1], r1[1]}; OUT = *reinterpret_cast<bf16x8*>(&w); } while (0)
    PK4(p0, 0, pa0); PK4(p0, 8, pa1); PK4(p1, 0, pa2); PK4(p1, 8, pa3);
#undef PK4
}

struct LaneCtx {
    int qpos;
    int nvis;
    unsigned mlo, mhi;
    int cur;
    float cq2;
    float m_fin, inv_l;
    int wave_qmax;
    float qn;
};
constexpr float DEFER_THR = 11.5f;
constexpr float IMP_SCALE = 67108864.f;

template <int MODE, int PASS>
__device__ __forceinline__ void attn_loop(LAS char* lds, const bf16_t* Kg, const bf16_t* Vg, int ldkv, const float* ckg, int t_lo, int t_hi,
                                          const bf16x8 (&qr)[8], const LaneCtx& cx, f32x16 (&o)[4], float& m_reg, float& l_reg) {
    const int tid = otid(), wid = __builtin_amdgcn_readfirstlane(tid >> 6), lane = tid & 63, r32 = lane & 31, hi = lane >> 5;
    LAS float* al_l = (LAS float*)(lds + OFF_WS) + wid * 64;
    const int sr = tid >> 4, sc = (tid & 15) * 8;
    const int kws = KSWZ(sr, sc * 2), vst0 = v_st(sr, sc), vst1 = v_st(32 + sr, sc);
    bf16x8 sk0, sk1, sv0, sv1; float sck = 0.f;
    const unsigned soff = (unsigned)(sr * ldkv + sc);
    const int nt = t_hi - t_lo;
#define AT_LOAD(t) do { const bf16_t* kt_ = Kg + (size_t)(64 * (t)) * ldkv; const bf16_t* kt2_ = kt_ + (size_t)32 * ldkv; sk0 = *(const bf16x8*)(kt_ + soff); sk1 = *(const bf16x8*)(kt2_ + soff); \
        if (PASS != 1) { const bf16_t* vt_ = Vg + (size_t)(64 * (t)) * ldkv; const bf16_t* vt2_ = vt_ + (size_t)32 * ldkv; sv0 = *(const bf16x8*)(vt_ + soff); sv1 = *(const bf16x8*)(vt2_ + soff); } \
        if (MODE == M_FOX) { if (tid < 64) sck = ckg[64 * (t) + tid]; } } while (0)
#define AT_WRITE(bf) do { LAS char* b_ = lds + (bf) * 32768; *(LAS bf16x8*)(b_ + OFF_K + kws) = sk0; *(LAS bf16x8*)(b_ + OFF_K + kws + 32 * 256) = sk1; \
        if (PASS != 1) { *(LAS bf16x8*)(b_ + OFF_V + vst0) = sv0; *(LAS bf16x8*)(b_ + OFF_V + vst1) = sv1; } \
        if (MODE == M_FOX) { if (tid < 64) ((LAS float*)(lds + OFF_CK))[(bf) * 64 + tid] = sck; } } while (0)
#define AT_TILE(i_) ((MODE == M_FOX) ? (t_hi - 1 - (i_)) : (t_lo + (i_)))
    if (nt > 0) AT_LOAD(AT_TILE(0));
    BAR_LDS();
    if (nt > 0) AT_WRITE(0);
    if (nt > 1) AT_LOAD(AT_TILE(1));
    if (MODE == M_FOX) { if (lane == 0) { ((LAS unsigned*)(lds + OFF_DEAD))[wid] = 0u; ((LAS unsigned*)(lds + OFF_DEAD))[8 + wid] = 0u; } }
    BAR_LDS();
    if (wid >= 4) __builtin_amdgcn_s_setprio(1);
    bool dead = false;
    for (int i = 0; i < nt; ++i) {
        const int t = AT_TILE(i), bf = i & 1;
        if (MODE == M_FOX) {
            if (i > 0) { const u32x4 d0_ = *(LAS const u32x4*)(lds + OFF_DEAD + ((i - 1) & 1) * 32), d1_ = *(LAS const u32x4*)(lds + OFF_DEAD + ((i - 1) & 1) * 32 + 16);
                if ((d0_.x & d0_.y & d0_.z & d0_.w & d1_.x & d1_.y & d1_.z & d1_.w) != 0u) break; }
            if (!dead) { const float ks_ = ((LAS const float*)(lds + OFF_FOXB))[t], cm_ = ((LAS const float*)(lds + OFF_FOXB))[64 + t];
                dead = __all(cx.qn * ks_ + cx.cq2 - cm_ - m_reg < -160.0f); }
            if (lane == 0) ((LAS unsigned*)(lds + OFF_DEAD))[(i & 1) * 8 + wid] = dead ? 1u : 0u;
        }
        LAS char* K_lds = lds + bf * 32768 + OFF_K;
        const unsigned vb0 = (unsigned)(size_t)(lds + bf * 32768 + OFF_V) + (unsigned)v_rd_base(lane);
        LAS float* ck_l = (LAS float*)(lds + OFF_CK) + bf * 64;
        const int kb = 64 * t;
        bool act = true;
        if (MODE == M_FOX) act = (kb <= cx.wave_qmax) && !dead;
        if (act) {
            f32x16 p0, p1;
            qkt(p0, p1, K_lds, r32, hi, qr);
            if (MODE == M_FOX) {
#pragma unroll
                for (int a = 0; a < 4; ++a) { const f32x4 c0 = *(LAS const f32x4*)(ck_l + 8 * a + 4 * hi), c1 = *(LAS const f32x4*)(ck_l + 32 + 8 * a + 4 * hi);
#pragma unroll
                    for (int j = 0; j < 4; ++j) { p0[4 * a + j] = p0[4 * a + j] + (cx.cq2 - c0[j]); p1[4 * a + j] = p1[4 * a + j] + (cx.cq2 - c1[j]); } }
            }
            constexpr float SC = 1.0f;
            int lo, len;
            if (MODE == M_WIN) { lo = cx.qpos - 511 - kb; len = 512; }
            else if (MODE == M_FOX) { lo = -64; len = cx.qpos - kb + 65; }
            else if (MODE == M_SLC) { if (t < cx.cur) { lo = 0; len = 64; } else { lo = -64; len = cx.qpos - kb + 65; } }
            else { lo = -64; len = cx.nvis - kb + 64; }
            if (!__all(lo <= 0 && lo + len >= 64)) mask_range(p0, p1, hi, lo, len);
            bool sel = true;
            if (MODE == M_SLC) sel = ((t < 32 ? (cx.mlo >> t) : (cx.mhi >> (t - 32))) & 1u) != 0u;
            if (PASS == 2) {
                const float mf = -cx.m_fin;
#pragma unroll
                for (int r = 0; r < 16; ++r) { p0[r] = __builtin_amdgcn_exp2f(fmaf(p0[r], SC, mf)) * cx.inv_l; p1[r] = __builtin_amdgcn_exp2f(fmaf(p1[r], SC, mf)) * cx.inv_l; }
                LAS unsigned* ip = (LAS unsigned*)(lds + OFF_IMP) + ((wid & 1) * 32 + r32) * 65;
#pragma unroll
                for (int a = 0; a < 4; ++a) {
                    const int jA = 16 * t + 2 * a + hi, jB = jA + 8;
                    const float s0 = (p0[4 * a] + p0[4 * a + 1]) + (p0[4 * a + 2] + p0[4 * a + 3]);
                    const float s1 = (p1[4 * a] + p1[4 * a + 1]) + (p1[4 * a + 2] + p1[4 * a + 3]);
                    __hip_atomic_fetch_add(ip + jA, (unsigned)(s0 * IMP_SCALE + 0.5f), __ATOMIC_RELAXED, __HIP_MEMORY_SCOPE_WORKGROUP);
                    __hip_atomic_fetch_add(ip + jB, (unsigned)(s1 * IMP_SCALE + 0.5f), __ATOMIC_RELAXED, __HIP_MEMORY_SCOPE_WORKGROUP);
                    if (jA + 1 < 64) __hip_atomic_fetch_add(ip + jA + 1, (unsigned)(p0[4 * a + 3] * IMP_SCALE + 0.5f), __ATOMIC_RELAXED, __HIP_MEMORY_SCOPE_WORKGROUP);
                    if (jB + 1 < 64) __hip_atomic_fetch_add(ip + jB + 1, (unsigned)(p1[4 * a + 3] * IMP_SCALE + 0.5f), __ATOMIC_RELAXED, __HIP_MEMORY_SCOPE_WORKGROUP);
                }
            } else {
                float pmax = p0[0];
#pragma unroll
                for (int r = 1; r < 16; ++r) pmax = fmaxf(pmax, p0[r]);
#pragma unroll
                for (int r = 0; r < 16; ++r) pmax = fmaxf(pmax, p1[r]);
                { auto rr = __builtin_amdgcn_permlane32_swap(__float_as_uint(pmax), __float_as_uint(pmax), false, false);
                  pmax = fmaxf(__uint_as_float(rr[0]), __uint_as_float(rr[1])); }
                pmax *= SC;
                if (MODE == M_SLC) pmax = sel ? pmax : -__builtin_inff();
                float alpha = 1.f;
                if (!__all(pmax - m_reg <= DEFER_THR)) {
                    const float mn = fmaxf(m_reg, pmax);
                    alpha = __builtin_amdgcn_exp2f(m_reg - mn); m_reg = mn;
                    if (PASS == 0) {
                        if (hi == 0) al_l[r32] = alpha;
                        asm volatile("s_waitcnt lgkmcnt(0)" ::: "memory");
#pragma unroll
                        for (int r = 0; r < 16; ++r) { const float av = al_l[crow(r, hi)];
#pragma unroll
                            for (int d = 0; d < 4; ++d) o[d][r] *= av; }
                    }
                }
                const float mneg = (MODE == M_SLC && !sel) ? -__builtin_inff() : -m_reg;
                float ps = 0.f;
#pragma unroll
                for (int r = 0; r < 16; ++r) { p0[r] = __builtin_amdgcn_exp2f(fmaf(p0[r], SC, mneg)); p1[r] = __builtin_amdgcn_exp2f(fmaf(p1[r], SC, mneg)); ps += p0[r] + p1[r]; }
                { auto rr = __builtin_amdgcn_permlane32_swap(__float_as_uint(ps), __float_as_uint(ps), false, false);
                  ps = __uint_as_float(rr[0]) + __uint_as_float(rr[1]); }
                l_reg = l_reg * alpha + ps;
            }
            if (PASS != 1) {
                bf16x8 pa0, pa1, pa2, pa3;
                pack_p(p0, p1, pa0, pa1, pa2, pa3);
                pv_tile(o, vb0, pa0, pa1, pa2, pa3);
            }
        }
        if (i + 1 < nt) { AT_WRITE(bf ^ 1); if (i + 2 < nt) AT_LOAD(AT_TILE(i + 2)); }
        BAR_LDS();
    }
    __builtin_amdgcn_s_setprio(0);
#undef AT_LOAD
#undef AT_WRITE
#undef AT_TILE
}

__device__ __forceinline__ void mask_half(f32x16& p, int hi, int lo, int len, int base) {
    const float NEG = -__builtin_inff(); const int b = base + 4 * hi - lo; const unsigned ul = (unsigned)(len < 0 ? 0 : len);
#pragma unroll
    for (int r = 0; r < 16; ++r) { const int c = (r & 3) + 8 * (r >> 2); if ((unsigned)(c + b) >= ul) p[r] = NEG; }
}
#define PK4H(P, B_, OUT) do { unsigned a0 = cvtpk(P[B_+0], P[B_+1]), a1 = cvtpk(P[B_+2], P[B_+3]); \
        unsigned b0 = cvtpk(P[B_+4], P[B_+5]), b1 = cvtpk(P[B_+6], P[B_+7]); \
        auto r0 = __builtin_amdgcn_permlane32_swap(a0, b0, false, false); auto r1 = __builtin_amdgcn_permlane32_swap(a1, b1, false, false); \
        u32x4 w = {r0[0], r1[0], r0[1], r1[1]}; OUT = *reinterpret_cast<bf16x8*>(&w); } while (0)
template <int MODE>
__device__ __forceinline__ void attn_loop_h(LAS char* lds, const bf16_t* Kg, const bf16_t* Vg, int ldkv, const float* ckg, int t_lo, int t_hi,
                                            const bf16x8 (&qr)[8], const LaneCtx& cx, f32x16 (&o)[4], float& m_reg, float& l_reg) {
    const int tid = otid(), wid = __builtin_amdgcn_readfirstlane(tid >> 6), lane = tid & 63, r32 = lane & 31, hi = lane >> 5;
    const int sr = tid >> 4, sc = (tid & 15) * 8;
    const int kws = KSWZ(sr, sc * 2), vst0 = v_st(sr, sc), vst1 = v_st(32 + sr, sc);
    bf16x8 sk0, sk1, sv0, sv1; float sck = 0.f;
    const unsigned soff = (unsigned)(sr * ldkv + sc);
    const int nt = t_hi - t_lo;
    LAS unsigned* tflag = (LAS unsigned*)(lds + OFF_CK + 1024);
  for (int pass = 0; ; ++pass) {
    l_reg = 0.f;
#pragma unroll
    for (int d = 0; d < 4; ++d)
#pragma unroll
        for (int r = 0; r < 16; ++r) o[d][r] = 0.f;
#define AT_LOAD(t) do { const bf16_t* kt_ = Kg + (size_t)(64 * (t)) * ldkv; const bf16_t* kt2_ = kt_ + (size_t)32 * ldkv; sk0 = *(const bf16x8*)(kt_ + soff); sk1 = *(const bf16x8*)(kt2_ + soff); \
        { const bf16_t* vt_ = Vg + (size_t)(64 * (t)) * ldkv; const bf16_t* vt2_ = vt_ + (size_t)32 * ldkv; sv0 = *(const bf16x8*)(vt_ + soff); sv1 = *(const bf16x8*)(vt2_ + soff); } \
        if (MODE == M_FOX) { if (tid < 64) sck = ckg[64 * (t) + tid]; } } while (0)
#define AT_WRITE(bf) do { LAS char* b_ = lds + (bf) * 32768; *(LAS bf16x8*)(b_ + OFF_K + kws) = sk0; *(LAS bf16x8*)(b_ + OFF_K + kws + 32 * 256) = sk1; \
        *(LAS bf16x8*)(b_ + OFF_V + vst0) = sv0; *(LAS bf16x8*)(b_ + OFF_V + vst1) = sv1; \
        if (MODE == M_FOX) { if (tid < 64) ((LAS float*)(lds + OFF_CK))[(bf) * 64 + tid] = sck; } } while (0)
#define AT_TILE(i_) ((MODE == M_FOX) ? (t_hi - 1 - (i_)) : (t_lo + (i_)))
    if (nt > 0) AT_LOAD(AT_TILE(0));
    BAR_LDS();
    if (nt > 0) AT_WRITE(0);
    if (nt > 1) AT_LOAD(AT_TILE(1));
    if (MODE == M_FOX) { if (lane == 0) { ((LAS unsigned*)(lds + OFF_DEAD))[wid] = 0u; ((LAS unsigned*)(lds + OFF_DEAD))[8 + wid] = 0u; } }
    BAR_LDS();
    if (wid >= 4) __builtin_amdgcn_s_setprio(1);
    bool dead = false;
    for (int i = 0; i < nt; ++i) {
        const int t = AT_TILE(i), bf = i & 1;
        if (MODE == M_FOX) {
            if (i > 0) { const u32x4 d0_ = *(LAS const u32x4*)(lds + OFF_DEAD + ((i - 1) & 1) * 32), d1_ = *(LAS const u32x4*)(lds + OFF_DEAD + ((i - 1) & 1) * 32 + 16);
                if ((d0_.x & d0_.y & d0_.z & d0_.w & d1_.x & d1_.y & d1_.z & d1_.w) != 0u) break; }
            if (!dead) { const float ks_ = ((LAS const float*)(lds + OFF_FOXB))[t], cm_ = ((LAS const float*)(lds + OFF_FOXB))[64 + t];
                dead = __all(cx.qn * ks_ + cx.cq2 - cm_ - m_reg < -160.0f); }
            if (lane == 0) ((LAS unsigned*)(lds + OFF_DEAD))[(i & 1) * 8 + wid] = dead ? 1u : 0u;
        }
        LAS const char* K_lds = lds + bf * 32768 + OFF_K;
        const unsigned vb0 = (unsigned)(size_t)(lds + bf * 32768 + OFF_V) + (unsigned)v_rd_base(lane);
        LAS const float* ck_l = (LAS const float*)(lds + OFF_CK) + bf * 64;
        const int kb = 64 * t;
        bool act = true;
        if (MODE == M_FOX) act = (kb <= cx.wave_qmax) && !dead;
        if (act) {
            int lo, len;
            if (MODE == M_WIN) { lo = cx.qpos - 511 - kb; len = 512; }
            else if (MODE == M_FOX) { lo = -64; len = cx.qpos - kb + 65; }
            else { if (t < cx.cur) { lo = 0; len = 64; } else { lo = -64; len = cx.qpos - kb + 65; } }
            const bool need_mask = !__all(lo <= 0 && lo + len >= 64);
            bool sel = true;
            if (MODE == M_SLC) sel = ((t < 32 ? (cx.mlo >> t) : (cx.mhi >> (t - 32))) & 1u) != 0u;
            LAS const char* kbp[4];
#pragma unroll
            for (int dd = 0; dd < 4; ++dd) kbp[dd] = K_lds + KSWZ(r32, (dd * 16 + hi * 8) * 2);
#define KFRAG(d0, HALF_) (*(LAS const bf16x8*)(kbp[(d0) & 3] + ((d0) >> 2) * 128 + (HALF_) * 32 * 256))
            f32x16 p0, p1; bf16x8 pa0, pa1, pa2, pa3; float ps = 0.f;
            { const float tb = ((MODE == M_FOX) ? cx.cq2 : 0.f) - m_reg;
#pragma unroll
              for (int r = 0; r < 16; ++r) p1[r] = tb; }
            {   bf16x8 f0 = KFRAG(0, 0), f1 = KFRAG(1, 0);
#pragma unroll
                for (int k = 0; k < 8; ++k) { p0 = __builtin_amdgcn_mfma_f32_32x32x16_bf16((k & 1) ? f1 : f0, qr[k], k == 0 ? p1 : p0, 0, 0, 0);
                    if (k + 2 < 8) { if (k & 1) f1 = KFRAG(k + 2, 0); else f0 = KFRAG(k + 2, 0); } }
            }
            if (MODE == M_FOX) {
#pragma unroll
                for (int a = 0; a < 4; ++a) { const f32x4 c0 = *(LAS const f32x4*)(ck_l + 8 * a + 4 * hi);
#pragma unroll
                    for (int j = 0; j < 4; ++j) p0[4 * a + j] -= c0[j]; }
            }
            if (need_mask) mask_half(p0, hi, lo, len, 0);
            {   bf16x8 f0 = KFRAG(0, 1), f1 = KFRAG(1, 1);
                SBAR();
#pragma unroll
                for (int k = 0; k < 8; ++k) { p1 = __builtin_amdgcn_mfma_f32_32x32x16_bf16((k & 1) ? f1 : f0, qr[k], p1, 0, 0, 0);
                    if (k + 2 < 8) { if (k & 1) f1 = KFRAG(k + 2, 1); else f0 = KFRAG(k + 2, 1); }
                    p0[2 * k] = __builtin_amdgcn_exp2f(p0[2 * k]); p0[2 * k + 1] = __builtin_amdgcn_exp2f(p0[2 * k + 1]); ps += p0[2 * k] + p0[2 * k + 1];
                    if (k == 3) { PK4H(p0, 0, pa0); if (MODE == M_SLC) pa0 = sel ? pa0 : (bf16x8){0, 0, 0, 0, 0, 0, 0, 0}; }
                    if (k == 7) { PK4H(p0, 8, pa1); if (MODE == M_SLC) pa1 = sel ? pa1 : (bf16x8){0, 0, 0, 0, 0, 0, 0, 0}; }
                    SBAR(); }
            }
#undef KFRAG
            if (MODE == M_FOX) {
#pragma unroll
                for (int a = 0; a < 4; ++a) { const f32x4 c1 = *(LAS const f32x4*)(ck_l + 32 + 8 * a + 4 * hi);
#pragma unroll
                    for (int j = 0; j < 4; ++j) p1[4 * a + j] -= c1[j]; }
            }
            if (need_mask) mask_half(p1, hi, lo, len, 32);
            {
#define TRRD(dst, off) asm volatile("ds_read_b64_tr_b16 %0, %1 offset:%2" : "=&v"(dst) : "v"(vb0), "i"(off) : "memory")
#define PV_OFF(k) (v_rd_off(((k) & 7) >> 1, 2 * ((k) >> 3) + ((k) & 1), 0))
#define PV_A(k) ((((k) >> 3) == 0) ? (((k) & 1) ? pa1 : pa0) : (((k) & 1) ? pa3 : pa2))
#define PV_STEP(k, L, H, VALU_) do { \
                if ((k) + 1 < 16) asm volatile("s_waitcnt lgkmcnt(2)" ::: "memory"); else asm volatile("s_waitcnt lgkmcnt(0)" ::: "memory"); \
                SBAR(); \
                o[((k) & 7) >> 1] = __builtin_amdgcn_mfma_f32_32x32x16_bf16(PV_A(k), (bf16x8){L[0], L[1], L[2], L[3], H[0], H[1], H[2], H[3]}, o[((k) & 7) >> 1], 0, 0, 0); \
                if ((k) + 2 < 16) { TRRD(L, PV_OFF((k) + 2)); TRRD(H, PV_OFF((k) + 2) + 2048); } \
                if (VALU_) { constexpr int kk_ = (k) & 7; \
                    p1[2 * kk_] = __builtin_amdgcn_exp2f(p1[2 * kk_]); p1[2 * kk_ + 1] = __builtin_amdgcn_exp2f(p1[2 * kk_ + 1]); ps += p1[2 * kk_] + p1[2 * kk_ + 1]; \
                    if (kk_ == 3) { PK4H(p1, 0, pa2); if (MODE == M_SLC) pa2 = sel ? pa2 : (bf16x8){0, 0, 0, 0, 0, 0, 0, 0}; } \
                    if (kk_ == 7) { PK4H(p1, 8, pa3); if (MODE == M_SLC) pa3 = sel ? pa3 : (bf16x8){0, 0, 0, 0, 0, 0, 0, 0}; } } \
                SBAR(); } while (0)
                s16x4 la, ha, lb, hb;
                TRRD(la, PV_OFF(0)); TRRD(ha, PV_OFF(0) + 2048); TRRD(lb, PV_OFF(1)); TRRD(hb, PV_OFF(1) + 2048);
                SBAR();
                PV_STEP(0, la, ha, true);  PV_STEP(1, lb, hb, true);  PV_STEP(2, la, ha, true);  PV_STEP(3, lb, hb, true);
                PV_STEP(4, la, ha, true);  PV_STEP(5, lb, hb, true);  PV_STEP(6, la, ha, true);  PV_STEP(7, lb, hb, true);
                PV_STEP(8, la, ha, false); PV_STEP(9, lb, hb, false); PV_STEP(10, la, ha, false); PV_STEP(11, lb, hb, false);
                PV_STEP(12, la, ha, false); PV_STEP(13, lb, hb, false); PV_STEP(14, la, ha, false); PV_STEP(15, lb, hb, false);
#undef PV_STEP
#undef PV_A
#undef PV_OFF
#undef TRRD
            }
            { auto rr = __builtin_amdgcn_permlane32_swap(__float_as_uint(ps), __float_as_uint(ps), false, false);
              ps = __uint_as_float(rr[0]) + __uint_as_float(rr[1]); }
            if (MODE == M_SLC) ps = sel ? ps : 0.f;
            l_reg += ps;
        }
        if (i + 1 < nt) { AT_WRITE(bf ^ 1); if (i + 2 < nt) AT_LOAD(AT_TILE(i + 2)); }
        BAR_LDS();
    }
    __builtin_amdgcn_s_setprio(0);
    if (pass != 0) break;
    { const bool bad = !(l_reg > 1e-30f && l_reg < 1e30f);
      const bool trig = !__all(!bad);
      if (lane == 0) tflag[wid] = trig ? 1u : 0u; }
    BAR_LDS();
    { const u32x4 f0_ = *(LAS const u32x4*)tflag, f1_ = *(LAS const u32x4*)(tflag + 4);
      if ((f0_.x | f0_.y | f0_.z | f0_.w | f1_.x | f1_.y | f1_.z | f1_.w) == 0u) break; }
    { float ms = -1e30f, ls = 0.f; attn_loop<MODE, 1>(lds, Kg, Vg, ldkv, ckg, t_lo, t_hi, qr, cx, o, ms, ls); m_reg = ms > -1e29f ? ms : 0.f; }
  }
#undef AT_LOAD
#undef AT_WRITE
#undef AT_TILE
}
__device__ __forceinline__ void rescale_pa(bf16x8& pa, float alpha) {
    u32x4 w = *reinterpret_cast<u32x4*>(&pa);
#pragma unroll
    for (int j = 0; j < 4; ++j) { const float lo = __uint_as_float(w[j] << 16) * alpha, hi = __uint_as_float(w[j] & 0xffff0000u) * alpha; w[j] = cvtpk(lo, hi); }
    pa = *reinterpret_cast<bf16x8*>(&w);
}
template <int MODE, int HALF>
__device__ __forceinline__ void m_check0(const f32x16& p, bool sel, LAS float* al_l, int r32, int hi, f32x16 (&o)[4], float& m_reg, float& l_reg, float& ps, bf16x8& pa0, bf16x8& pa1) {
    constexpr float SC = 1.0f;
    float pm = p[0];
#pragma unroll
    for (int r = 1; r < 16; ++r) pm = fmaxf(pm, p[r]);
    { auto rr = __builtin_amdgcn_permlane32_swap(__float_as_uint(pm), __float_as_uint(pm), false, false);
      pm = fmaxf(__uint_as_float(rr[0]), __uint_as_float(rr[1])); }
    pm *= SC;
    if (MODE == M_SLC) pm = sel ? pm : -__builtin_inff();
    if (!__all(pm - m_reg <= DEFER_THR)) {
        const float mn = fmaxf(m_reg, pm);
        const float alpha = __builtin_amdgcn_exp2f(m_reg - mn); m_reg = mn;
        if (hi == 0) al_l[r32] = alpha;
        asm volatile("s_waitcnt lgkmcnt(0)" ::: "memory");
#pragma unroll
        for (int r = 0; r < 16; ++r) { const float av = al_l[crow(r, hi)];
#pragma unroll
            for (int d = 0; d < 4; ++d) o[d][r] *= av; }
        l_reg *= alpha;
        if (HALF == 1) { ps *= alpha; rescale_pa(pa0, alpha); rescale_pa(pa1, alpha); }
    }
}
template <int MODE>
__device__ __forceinline__ void attn_loop_h0(LAS char* lds, const bf16_t* Kg, const bf16_t* Vg, int ldkv, const float* ckg, int t_lo, int t_hi,
                                            const bf16x8 (&qr)[8], const LaneCtx& cx, f32x16 (&o)[4], float& m_reg, float& l_reg) {
    const int tid = otid(), wid = __builtin_amdgcn_readfirstlane(tid >> 6), lane = tid & 63, r32 = lane & 31, hi = lane >> 5;
    LAS float* al_l = (LAS float*)(lds + OFF_WS) + wid * 64;
    const int sr = tid >> 4, sc = (tid & 15) * 8;
    const int kws = KSWZ(sr, sc * 2), vst0 = v_st(sr, sc), vst1 = v_st(32 + sr, sc);
    bf16x8 sk0, sk1, sv0, sv1; float sck = 0.f;
    const unsigned soff = (unsigned)(sr * ldkv + sc);
    const int nt = t_hi - t_lo;
    constexpr float SC = 1.0f;
#define AT_LOAD(t) do { const bf16_t* kt_ = Kg + (size_t)(64 * (t)) * ldkv; const bf16_t* kt2_ = kt_ + (size_t)32 * ldkv; sk0 = *(const bf16x8*)(kt_ + soff); sk1 = *(const bf16x8*)(kt2_ + soff); \
        { const bf16_t* vt_ = Vg + (size_t)(64 * (t)) * ldkv; const bf16_t* vt2_ = vt_ + (size_t)32 * ldkv; sv0 = *(const bf16x8*)(vt_ + soff); sv1 = *(const bf16x8*)(vt2_ + soff); } \
        if (MODE == M_FOX) { if (tid < 64) sck = ckg[64 * (t) + tid]; } } while (0)
#define AT_WRITE(bf) do { LAS char* b_ = lds + (bf) * 32768; *(LAS bf16x8*)(b_ + OFF_K + kws) = sk0; *(LAS bf16x8*)(b_ + OFF_K + kws + 32 * 256) = sk1; \
        *(LAS bf16x8*)(b_ + OFF_V + vst0) = sv0; *(LAS bf16x8*)(b_ + OFF_V + vst1) = sv1; \
        if (MODE == M_FOX) { if (tid < 64) ((LAS float*)(lds + OFF_CK))[(bf) * 64 + tid] = sck; } } while (0)
#define AT_TILE(i_) ((MODE == M_FOX) ? (t_hi - 1 - (i_)) : (t_lo + (i_)))
    if (nt > 0) AT_LOAD(AT_TILE(0));
    BAR_LDS();
    if (nt > 0) AT_WRITE(0);
    if (nt > 1) AT_LOAD(AT_TILE(1));
    if (MODE == M_FOX) { if (lane == 0) { ((LAS unsigned*)(lds + OFF_DEAD))[wid] = 0u; ((LAS unsigned*)(lds + OFF_DEAD))[8 + wid] = 0u; } }
    BAR_LDS();
    if (wid >= 4) __builtin_amdgcn_s_setprio(1);
    bool dead = false;
    for (int i = 0; i < nt; ++i) {
        const int t = AT_TILE(i), bf = i & 1;
        if (MODE == M_FOX) {
            if (i > 0) { const u32x4 d0_ = *(LAS const u32x4*)(lds + OFF_DEAD + ((i - 1) & 1) * 32), d1_ = *(LAS const u32x4*)(lds + OFF_DEAD + ((i - 1) & 1) * 32 + 16);
                if ((d0_.x & d0_.y & d0_.z & d0_.w & d1_.x & d1_.y & d1_.z & d1_.w) != 0u) break; }
            if (!dead) { const float ks_ = ((LAS const float*)(lds + OFF_FOXB))[t], cm_ = ((LAS const float*)(lds + OFF_FOXB))[64 + t];
                dead = __all(cx.qn * ks_ + cx.cq2 - cm_ - m_reg < -160.0f); }
            if (lane == 0) ((LAS unsigned*)(lds + OFF_DEAD))[(i & 1) * 8 + wid] = dead ? 1u : 0u;
        }
        LAS const char* K_lds = lds + bf * 32768 + OFF_K;
        const unsigned vb0 = (unsigned)(size_t)(lds + bf * 32768 + OFF_V) + (unsigned)v_rd_base(lane);
        LAS const float* ck_l = (LAS const float*)(lds + OFF_CK) + bf * 64;
        const int kb = 64 * t;
        bool act = true;
        if (MODE == M_FOX) act = (kb <= cx.wave_qmax) && !dead;
        if (act) {
            int lo, len;
            if (MODE == M_WIN) { lo = cx.qpos - 511 - kb; len = 512; }
            else if (MODE == M_FOX) { lo = -64; len = cx.qpos - kb + 65; }
            else { if (t < cx.cur) { lo = 0; len = 64; } else { lo = -64; len = cx.qpos - kb + 65; } }
            const bool need_mask = !__all(lo <= 0 && lo + len >= 64);
            bool sel = true;
            if (MODE == M_SLC) sel = ((t < 32 ? (cx.mlo >> t) : (cx.mhi >> (t - 32))) & 1u) != 0u;
            LAS const char* kbp[4];
#pragma unroll
            for (int dd = 0; dd < 4; ++dd) kbp[dd] = K_lds + KSWZ(r32, (dd * 16 + hi * 8) * 2);
#define KFRAG(d0, HALF_) (*(LAS const bf16x8*)(kbp[(d0) & 3] + ((d0) >> 2) * 128 + (HALF_) * 32 * 256))
            f32x16 p0, p1; bf16x8 pa0, pa1, pa2, pa3; float ps = 0.f;
            {   bf16x8 f0 = KFRAG(0, 0), f1 = KFRAG(1, 0);
#pragma unroll
                for (int r = 0; r < 16; ++r) p0[r] = 0.f;
#pragma unroll
                for (int k = 0; k < 8; ++k) { p0 = __builtin_amdgcn_mfma_f32_32x32x16_bf16((k & 1) ? f1 : f0, qr[k], p0, 0, 0, 0);
                    if (k + 2 < 8) { if (k & 1) f1 = KFRAG(k + 2, 0); else f0 = KFRAG(k + 2, 0); } }
            }
            if (MODE == M_FOX) {
#pragma unroll
                for (int a = 0; a < 4; ++a) { const f32x4 c0 = *(LAS const f32x4*)(ck_l + 8 * a + 4 * hi);
#pragma unroll
                    for (int j = 0; j < 4; ++j) p0[4 * a + j] += cx.cq2 - c0[j]; }
            }
            if (need_mask) mask_half(p0, hi, lo, len, 0);
            m_check0<MODE, 0>(p0, sel, al_l, r32, hi, o, m_reg, l_reg, ps, pa0, pa1);
            float mneg = (MODE == M_SLC && !sel) ? -__builtin_inff() : -m_reg;
            {   bf16x8 f0 = KFRAG(0, 1), f1 = KFRAG(1, 1);
#pragma unroll
                for (int r = 0; r < 16; ++r) p1[r] = 0.f;
                SBAR();
#pragma unroll
                for (int k = 0; k < 8; ++k) { p1 = __builtin_amdgcn_mfma_f32_32x32x16_bf16((k & 1) ? f1 : f0, qr[k], p1, 0, 0, 0);
                    if (k + 2 < 8) { if (k & 1) f1 = KFRAG(k + 2, 1); else f0 = KFRAG(k + 2, 1); }
                    p0[2 * k] = __builtin_amdgcn_exp2f(fmaf(p0[2 * k], SC, mneg)); p0[2 * k + 1] = __builtin_amdgcn_exp2f(fmaf(p0[2 * k + 1], SC, mneg)); ps += p0[2 * k] + p0[2 * k + 1];
                    if (k == 3) PK4H(p0, 0, pa0);
                    if (k == 7) PK4H(p0, 8, pa1);
                    SBAR(); }
            }
#undef KFRAG
            if (MODE == M_FOX) {
#pragma unroll
                for (int a = 0; a < 4; ++a) { const f32x4 c1 = *(LAS const f32x4*)(ck_l + 32 + 8 * a + 4 * hi);
#pragma unroll
                    for (int j = 0; j < 4; ++j) p1[4 * a + j] += cx.cq2 - c1[j]; }
            }
            if (need_mask) mask_half(p1, hi, lo, len, 32);
            m_check0<MODE, 1>(p1, sel, al_l, r32, hi, o, m_reg, l_reg, ps, pa0, pa1);
            mneg = (MODE == M_SLC && !sel) ? -__builtin_inff() : -m_reg;
            {
#define TRRD(dst, off) asm volatile("ds_read_b64_tr_b16 %0, %1 offset:%2" : "=&v"(dst) : "v"(vb0), "i"(off) : "memory")
#define PV_OFF(k) (v_rd_off(((k) & 7) >> 1, 2 * ((k) >> 3) + ((k) & 1), 0))
#define PV_A(k) ((((k) >> 3) == 0) ? (((k) & 1) ? pa1 : pa0) : (((k) & 1) ? pa3 : pa2))
#define PV_STEP(k, L, H, VALU_) do { \
                if ((k) + 1 < 16) asm volatile("s_waitcnt lgkmcnt(2)" ::: "memory"); else asm volatile("s_waitcnt lgkmcnt(0)" ::: "memory"); \
                SBAR(); \
                o[((k) & 7) >> 1] = __builtin_amdgcn_mfma_f32_32x32x16_bf16(PV_A(k), (bf16x8){L[0], L[1], L[2], L[3], H[0], H[1], H[2], H[3]}, o[((k) & 7) >> 1], 0, 0, 0); \
                if ((k) + 2 < 16) { TRRD(L, PV_OFF((k) + 2)); TRRD(H, PV_OFF((k) + 2) + 2048); } \
                if (VALU_) { constexpr int kk_ = (k) & 7; \
                    p1[2 * kk_] = __builtin_amdgcn_exp2f(fmaf(p1[2 * kk_], SC, mneg)); p1[2 * kk_ + 1] = __builtin_amdgcn_exp2f(fmaf(p1[2 * kk_ + 1], SC, mneg)); ps += p1[2 * kk_] + p1[2 * kk_ + 1]; \
                    if (kk_ == 3) PK4H(p1, 0, pa2); \
                    if (kk_ == 7) PK4H(p1, 8, pa3); } \
                SBAR(); } while (0)
                s16x4 la, ha, lb, hb;
                TRRD(la, PV_OFF(0)); TRRD(ha, PV_OFF(0) + 2048); TRRD(lb, PV_OFF(1)); TRRD(hb, PV_OFF(1) + 2048);
                SBAR();
                PV_STEP(0, la, ha, true);  PV_STEP(1, lb, hb, true);  PV_STEP(2, la, ha, true);  PV_STEP(3, lb, hb, true);
                PV_STEP(4, la, ha, true);  PV_STEP(5, lb, hb, true);  PV_STEP(6, la, ha, true);  PV_STEP(7, lb, hb, true);
                PV_STEP(8, la, ha, false); PV_STEP(9, lb, hb, false); PV_STEP(10, la, ha, false); PV_STEP(11, lb, hb, false);
                PV_STEP(12, la, ha, false); PV_STEP(13, lb, hb, false); PV_STEP(14, la, ha, false); PV_STEP(15, lb, hb, false);
#undef PV_STEP
#undef PV_A
#undef PV_OFF
#undef TRRD
            }
            { auto rr = __builtin_amdgcn_permlane32_swap(__float_as_uint(ps), __float_as_uint(ps), false, false);
              ps = __uint_as_float(rr[0]) + __uint_as_float(rr[1]); }
            l_reg += ps;
        }
        if (i + 1 < nt) { AT_WRITE(bf ^ 1); if (i + 2 < nt) AT_LOAD(AT_TILE(i + 2)); }
        BAR_LDS();
    }
    __builtin_amdgcn_s_setprio(0);
#undef AT_LOAD
#undef AT_WRITE
#undef AT_TILE
}
#undef PK4H

#define DPPX(v, ctrl) ((unsigned)__builtin_amdgcn_update_dpp(0, (int)(v), (ctrl), 0xF, 0xF, true))
__device__ __forceinline__ void attn_store(LAS char* lds, const f32x16 (&o)[4], float rowscale, bf16_t* outbase, unsigned rowstride) {
    const int tid = otid(), wid = __builtin_amdgcn_readfirstlane(tid >> 6), lane = tid & 63, r32 = lane & 31, hi = lane >> 5;
    LAS float* li_l = (LAS float*)(lds + OFF_WS) + wid * 64 + 32;
    if (hi == 0) li_l[r32] = rowscale;
    asm volatile("s_waitcnt lgkmcnt(0)" ::: "memory");
    float f[16];
#pragma unroll
    for (int r = 0; r < 16; ++r) f[r] = li_l[crow(r, hi)];
    const bool b0 = (lane & 1) != 0, b1 = (lane & 2) != 0, b2 = (lane & 4) != 0;
    const int j = lane & 7;
    bf16_t* p0 = outbase + (size_t)crow(j, hi) * rowstride + (r32 & 24);
#pragma unroll
    for (int d0 = 0; d0 < 4; ++d0) {
        unsigned P[8];
#pragma unroll
        for (int rp = 0; rp < 8; ++rp) { const float a = o[d0][2 * rp] * f[2 * rp], b = o[d0][2 * rp + 1] * f[2 * rp + 1];
            const float snd = b0 ? a : b;
            const float rcv = __uint_as_float(DPPX(__float_as_uint(snd), 0xB1));
            P[rp] = cvtpk(b0 ? rcv : a, b0 ? b : rcv); }
        unsigned I[4][2];
#pragma unroll
        for (int q = 0; q < 4; ++q) { const unsigned snd = b1 ? P[2 * q] : P[2 * q + 1];
            const unsigned rcv = DPPX(snd, 0x4E);
            I[q][0] = b1 ? rcv : P[2 * q]; I[q][1] = b1 ? P[2 * q + 1] : rcv; }
#pragma unroll
        for (int h = 0; h < 2; ++h) { const unsigned s0 = b2 ? I[2 * h][0] : I[2 * h + 1][0], s1 = b2 ? I[2 * h][1] : I[2 * h + 1][1];
            const unsigned r0 = DPPX(DPPX(s0, 0x1B), 0x141), r1 = DPPX(DPPX(s1, 0x1B), 0x141);
            u32x4 w;
            w.x = b2 ? r0 : I[2 * h][0]; w.y = b2 ? r1 : I[2 * h][1]; w.z = b2 ? I[2 * h + 1][0] : r0; w.w = b2 ? I[2 * h + 1][1] : r1;
            *(u32x4*)(p0 + (size_t)(16 * h) * rowstride + d0 * 32) = w; }
    }
}
#undef DPPX
}
#ifndef PT_MODES
#define PT_MODES 7
#endif
#if PT_MODES & 1
#define PTL_WIN at::attn_loop_h<at::M_WIN>
#else
#define PTL_WIN at::attn_loop<at::M_WIN, 0>
#endif
#if PT_MODES & 2
#define PTL_SLC at::attn_loop_h<at::M_SLC>
#else
#define PTL_SLC at::attn_loop<at::M_SLC, 0>
#endif
#if PT_MODES & 4
#define PTL_FOX at::attn_loop_h0<at::M_FOX>
#else
#define PTL_FOX at::attn_loop<at::M_FOX, 0>
#endif

struct Params { const float* in[20]; float* out; unsigned char* ws; int ph_lo, ph_hi; };
enum { I_X = 0, I_NORM1, I_WIN, I_PE, I_CW1, I_CW2, I_POOLW, I_POOLS, I_FB, I_MIXG, I_WOUT, I_NORM2, I_FWG, I_FWU, I_FWD, I_ROUTER, I_MWG, I_MWU, I_MWD, I_FNORM };

__device__ __forceinline__ float bf2f(bf16_t v) { return __uint_as_float(((unsigned)v) << 16); }
__device__ __forceinline__ float sigmoidf_(float z) { return 1.0f / (1.0f + __expf(-z)); }

__device__ __forceinline__ void nsa_item(LAS char* lds, const Params& P, int bg, int qb) {
    using namespace at;
    const int tid = otid(), wid = __builtin_amdgcn_readfirstlane(tid >> 6), lane = tid & 63, r32 = lane & 31, hi = lane >> 5;
    const int b = bg >> 1, g = bg & 1, head = g * 4 + (wid >> 1), qi = (wid & 1) * 32 + r32;
    const bf16_t* proj = (const bf16_t*)(P.ws + WS_PROJ);
    const float* gf = (const float*)(P.ws + WS_GF);
    bf16_t* mix = (bf16_t*)(P.ws + WS_MIX);
    const bf16_t* kcb = (const bf16_t*)(P.ws + WS_KC);
    const size_t trow = (size_t)b * SEQ + 64 * qb + qi;
    LaneCtx cx; cx.qpos = 64 * qb + qi; cx.nvis = cx.qpos >= 31 ? (cx.qpos - 31) / 16 + 1 : 0; cx.mlo = 0; cx.mhi = 0; cx.cur = qb; cx.cq2 = 0.f; cx.m_fin = 0.f; cx.inv_l = 0.f; cx.wave_qmax = 0; cx.qn = 0.f;
    bf16x8 qr[8];
    { const bf16_t* qp = proj + trow * NPROJ + PC_Q + head * 128 + hi * 8;
#pragma unroll
      for (int d0 = 0; d0 < 8; ++d0) qr[d0] = *(const bf16x8*)(qp + d0 * 16); }
    const float g0 = sigmoidf_(gf[trow * 32 + head * 3 + 0]), g1 = sigmoidf_(gf[trow * 32 + head * 3 + 1]), g2 = sigmoidf_(gf[trow * 32 + head * 3 + 2]);
    bf16_t* outbase = mix + ((size_t)b * SEQ + 64 * qb + (wid & 1) * 32) * 4096 + head * 128;
    f32x16 o[4];
    float m_reg, l_reg;
    const int ncv = 4 * qb + 3;
    const int ntc = (ncv + 63) / 64;
    const bf16_t* Kc = kcb + (size_t)(0 * 8 + bg) * 256 * 128; const bf16_t* Vc = kcb + (size_t)(1 * 8 + bg) * 256 * 128;
    m_reg = -1e30f; l_reg = 0.f;
    attn_loop<M_CMP, 1>(lds, Kc, Vc, 128, nullptr, 0, ntc, qr, cx, o, m_reg, l_reg);
    cx.m_fin = m_reg; cx.inv_l = l_reg > 0.f ? 1.0f / l_reg : 0.f;
    for (int i = tid; i < 64 * 65; i += 512) ((LAS unsigned*)(lds + OFF_IMP))[i] = 0u;
#pragma unroll
    for (int d = 0; d < 4; ++d)
#pragma unroll
        for (int r = 0; r < 16; ++r) o[d][r] = 0.f;
    attn_loop<M_CMP, 2>(lds, Kc, Vc, 128, nullptr, 0, ntc, qr, cx, o, m_reg, l_reg);
    attn_store(lds, o, g0, outbase, 4096u);
    {
        LAS unsigned* IMP = (LAS unsigned*)(lds + OFF_IMP); LAS unsigned* MSK = (LAS unsigned*)(lds + OFF_MASK);
        for (int idx = tid; idx < 4096; idx += 512) { const int q = idx >> 6, j = idx & 63;
            const unsigned v = IMP[q * 65 + j];
            const bool forced = (j == 0) || (j == qb) || (j == qb - 1), valid = j <= qb;
            IMP[q * 65 + j] = forced ? 0xFFFFFFFFu : (valid ? v + 1u : 0u); }
        BAR_LDS();
        const int q = tid >> 3, jg = tid & 7;
        unsigned mv[8]; int rank[8];
#pragma unroll
        for (int jj = 0; jj < 8; ++jj) { mv[jj] = IMP[q * 65 + jg * 8 + jj]; rank[jj] = 0; }
        for (int j2 = 0; j2 < 64; ++j2) { const unsigned x = IMP[q * 65 + j2];
#pragma unroll
            for (int jj = 0; jj < 8; ++jj) rank[jj] += (x > mv[jj] || (x == mv[jj] && j2 < jg * 8 + jj)) ? 1 : 0; }
        unsigned bits = 0;
#pragma unroll
        for (int jj = 0; jj < 8; ++jj) bits |= (rank[jj] < 16 ? 1u : 0u) << jj;
        unsigned lo = jg < 4 ? bits << (8 * jg) : 0u, hw = jg >= 4 ? bits << (8 * (jg - 4)) : 0u;
        lo |= __shfl_xor(lo, 1); hw |= __shfl_xor(hw, 1); lo |= __shfl_xor(lo, 2); hw |= __shfl_xor(hw, 2); lo |= __shfl_xor(lo, 4); hw |= __shfl_xor(hw, 4);
        if (jg == 0) { MSK[2 * q] = lo; MSK[2 * q + 1] = hw; }
        BAR_LDS();
        cx.mlo = MSK[2 * qi]; cx.mhi = MSK[2 * qi + 1];
    }
#pragma unroll
    for (int d = 0; d < 4; ++d)
#pragma unroll
        for (int r = 0; r < 16; ++r) o[d][r] = 0.f;
    m_reg = REF0; l_reg = 0.f;
    { const bf16_t* Ks = proj + (size_t)b * SEQ * NPROJ + PC_KS + g * 128; const bf16_t* Vs = proj + (size_t)b * SEQ * NPROJ + PC_VS + g * 128;
      PTL_SLC(lds, Ks, Vs, NPROJ, nullptr, 0, qb + 1, qr, cx, o, m_reg, l_reg); }
    attn_store(lds, o, l_reg > 0.f ? g1 / l_reg : 0.f, outbase + 1024, 4096u);
#pragma unroll
    for (int d = 0; d < 4; ++d)
#pragma unroll
        for (int r = 0; r < 16; ++r) o[d][r] = 0.f;
    m_reg = REF0; l_reg = 0.f;
    { const bf16_t* Kw = proj + (size_t)b * SEQ * NPROJ + PC_KW + g * 128; const bf16_t* Vw = proj + (size_t)b * SEQ * NPROJ + PC_VW + g * 128;
      PTL_WIN(lds, Kw, Vw, NPROJ, nullptr, qb >= 8 ? qb - 8 : 0, qb + 1, qr, cx, o, m_reg, l_reg); }
    attn_store(lds, o, l_reg > 0.f ? g2 / l_reg : 0.f, outbase + 2048, 4096u);
    BAR_LDS();
}

__device__ __forceinline__ void fox_item(LAS char* lds, const Params& P, int bh, int qb) {
    using namespace at;
    const int tid = otid(), wid = __builtin_amdgcn_readfirstlane(tid >> 6), lane = tid & 63, r32 = lane & 31, hi = lane >> 5;
    const int b = bh >> 2, h = bh & 3;
    const bf16_t* proj = (const bf16_t*)(P.ws + WS_PROJ);
    const float* cum = (const float*)(P.ws + WS_CUM) + (size_t)bh * SEQ;
    bf16_t* mix = (bf16_t*)(P.ws + WS_MIX);
    const int qpos = 256 * qb + wid * 32 + r32;
    const size_t trow = (size_t)b * SEQ + qpos;
    LaneCtx cx; cx.qpos = qpos; cx.nvis = 0; cx.mlo = 0; cx.mhi = 0; cx.cur = 0; cx.cq2 = cum[qpos]; cx.m_fin = 0.f; cx.inv_l = 0.f; cx.wave_qmax = 256 * qb + wid * 32 + 31; cx.qn = 0.f;
    bf16x8 qr[8];
    { const bf16_t* qp = proj + trow * NPROJ + PC_FQ + h * 128 + hi * 8;
#pragma unroll
      for (int d0 = 0; d0 < 8; ++d0) qr[d0] = *(const bf16x8*)(qp + d0 * 16); }
    { float ss = 0.f;
#pragma unroll
      for (int d0 = 0; d0 < 8; ++d0)
#pragma unroll
          for (int e = 0; e < 8; ++e) { const float v = bf2f((bf16_t)qr[d0][e]); ss += v * v; }
      auto rr = __builtin_amdgcn_permlane32_swap(__float_as_uint(ss), __float_as_uint(ss), false, false);
      cx.qn = sqrtf(__uint_as_float(rr[0]) + __uint_as_float(rr[1])); }
    if (tid < 64) { const float* ksg = (const float*)(P.ws + WS_KSG) + bh * 64;
        float kx = ksg[tid];
#pragma unroll
        for (int o = 1; o < 64; o <<= 1) { const float t2 = __shfl_up(kx, o); if (lane >= o) kx = fmaxf(kx, t2); }
        ((LAS float*)(lds + OFF_FOXB))[tid] = kx * 1.01f;
        ((LAS float*)(lds + OFF_FOXB))[64 + tid] = cum[64 * tid + 63]; }
    f32x16 o[4];
#pragma unroll
    for (int d = 0; d < 4; ++d)
#pragma unroll
        for (int r = 0; r < 16; ++r) o[d][r] = 0.f;
    float m_reg = 0.f, l_reg = 0.f;
    const bf16_t* Kf = proj + (size_t)b * SEQ * NPROJ + PC_FK + h * 128; const bf16_t* Vf = proj + (size_t)b * SEQ * NPROJ + PC_FV + h * 128;
    PTL_FOX(lds, Kf, Vf, NPROJ, cum, 0, 4 * (qb + 1), qr, cx, o, m_reg, l_reg);
    bf16_t* outbase = mix + ((size_t)b * SEQ + 256 * qb + wid * 32) * 4096 + 3584 + h * 128;
    attn_store(lds, o, l_reg > 0.f ? 1.0f / l_reg : 0.f, outbase, 4096u);
    BAR_LDS();
}

enum { XK_ID = 0, XK_INPROJ = 1, XK_GU = 2 };
__device__ __forceinline__ void xpose_tile(const float* src0, const float* src1, int ldsrc, int kind, const float* scale, bf16_t* dst, int K, int k0, int n0) {
    const int lane = otid() & 63;
    const int np = n0 + lane;
    const float* sp = src0; int col = np;
    if (kind == XK_INPROJ) {
        if (np < 2560) col = np; else if (np < 3072) col = np - 2560 + 2584; else if (np < 4608) col = np - 3072 + 3096; else if (np < 4632) col = np - 4608 + 2560; else if (np < 4636) col = np; else col = -1;
    } else if (kind == XK_GU) { const int pn = np >> 8, rr = np & 255; col = pn * 128 + (rr & 127); sp = (rr >= 128) ? src1 : src0; }
    const bool ok = col >= 0; if (!ok) col = 0;
    const float* p = sp + (size_t)k0 * ldsrc + col;
    float v[64];
#pragma unroll
    for (int kk = 0; kk < 64; ++kk) v[kk] = p[(size_t)kk * ldsrc];
    if (scale) {
#pragma unroll
        for (int kk = 0; kk < 64; ++kk) v[kk] *= scale[k0 + kk]; }
    bf16_t* dp = dst + (size_t)np * K + k0;
#pragma unroll
    for (int c = 0; c < 8; ++c) { u32x4 w;
        w.x = pg8::cvt_pk_bf16(v[c * 8 + 0], v[c * 8 + 1]); w.y = pg8::cvt_pk_bf16(v[c * 8 + 2], v[c * 8 + 3]); w.z = pg8::cvt_pk_bf16(v[c * 8 + 4], v[c * 8 + 5]); w.w = pg8::cvt_pk_bf16(v[c * 8 + 6], v[c * 8 + 7]);
        if (!ok) w = (u32x4){0u, 0u, 0u, 0u};
        *(u32x4*)(dp + c * 8) = w; }
}
struct XJob { const float* s0; const float* s1; const float* scale; bf16_t* dst; int ld, kind, K, k0, n0, f8; };
constexpr int XP = 262;
constexpr int XP8 = 260;
constexpr float WSCALE8 = 64.f;
__device__ __forceinline__ void xload(const XJob& j, int wid, int lane, f32x4 (&v)[8]) {
    const int np = j.n0 + 4 * lane;
    const float* sp = j.s0; int col = np;
    if (j.kind == XK_INPROJ) {
        if (np < 2560) col = np; else if (np < 3072) col = np - 2560 + 2584; else if (np < 4608) col = np - 3072 + 3096; else if (np < 4632) col = np - 4608 + 2560; else if (np < 4636) col = np; else col = -1;
    } else if (j.kind == XK_GU) { const int pn = np >> 8, rr = np & 255; col = pn * 128 + (rr & 127); sp = (rr >= 128) ? j.s1 : j.s0; }
    const bool ok = col >= 0; if (!ok) col = 0;
    const float* p = sp + (size_t)(j.k0 + wid) * j.ld + col;
#pragma unroll
    for (int r = 0; r < 8; ++r) { v[r] = __builtin_nontemporal_load((const f32x4*)(p + (size_t)(8 * r) * j.ld)); }
    if (!ok) {
#pragma unroll
        for (int r = 0; r < 8; ++r) v[r] = (f32x4){0.f, 0.f, 0.f, 0.f}; }
}
__device__ __forceinline__ void xstore_lds(LAS unsigned char* lds, const XJob& j, int wid, int lane, const f32x4 (&v)[8]) {
    LAS unsigned* tl = (LAS unsigned*)lds;
#pragma unroll
    for (int r = 0; r < 8; ++r) { const int k = wid + 8 * r; float sc = j.scale ? j.scale[j.k0 + k] : 1.0f;
        if (j.f8) { sc *= WSCALE8; tl[k * (XP8 / 4) + lane] = pg8::pack_fp8x4(v[r][0] * sc, v[r][1] * sc, v[r][2] * sc, v[r][3] * sc); }
        else { tl[k * (XP / 2) + 2 * lane] = pg8::cvt_pk_bf16(v[r][0] * sc, v[r][1] * sc); tl[k * (XP / 2) + 2 * lane + 1] = pg8::cvt_pk_bf16(v[r][2] * sc, v[r][3] * sc); } }
}
__device__ __forceinline__ void xwrite_out(LAS unsigned char* lds, const XJob& j, int tid) {
    if (j.f8) {
        LAS const unsigned char* tb = (LAS const unsigned char*)lds;
#pragma unroll
        for (int i = 0; i < 2; ++i) { const int c = tid + 512 * i, row = c >> 2, kc = c & 3;
            unsigned w[4];
#pragma unroll
            for (int q4 = 0; q4 < 4; ++q4) { unsigned x = 0;
#pragma unroll
                for (int q = 0; q < 4; ++q) x |= (unsigned)tb[(kc * 16 + q4 * 4 + q) * XP8 + row] << (8 * q);
                w[q4] = x; }
            *(u32x4*)((unsigned char*)j.dst + (size_t)(j.n0 + row) * j.K + j.k0 + kc * 16) = (u32x4){w[0], w[1], w[2], w[3]}; }
        return;
    }
    LAS const bf16_t* tl = (LAS const bf16_t*)lds;
#pragma unroll
    for (int i = 0; i < 4; ++i) { const int c = tid + 512 * i, row = c >> 3, kc = c & 7;
        unsigned short e[8];
#pragma unroll
        for (int q = 0; q < 8; ++q) e[q] = tl[(kc * 8 + q) * XP + row];
        u32x4 w; w.x = (unsigned)e[0] | ((unsigned)e[1] << 16); w.y = (unsigned)e[2] | ((unsigned)e[3] << 16); w.z = (unsigned)e[4] | ((unsigned)e[5] << 16); w.w = (unsigned)e[6] | ((unsigned)e[7] << 16);
        *(u32x4*)(j.dst + (size_t)(j.n0 + row) * j.K + j.k0 + kc * 8) = w; }
}
constexpr int BT0 = 4 * 32 * 19, BT1 = BT0 + 4 * 32 * 8, BT2 = BT1 + 2 * 32 * 44, BT3 = BT2 + 2 * 88 * 8, BT4 = BT3 + 16 * 32 * 28, BT5 = BT4 + 16 * 56 * 8;
__device__ __forceinline__ XJob xjob(const Params& P, int bt_) {
    const int bt = BT5 - 1 - bt_;
    unsigned char* ws = P.ws; XJob j;
    if (bt < BT0) { const int inst = bt / 608, r = bt % 608, kt = r & 31, nt = r >> 5;
        j = XJob{P.in[I_WIN] + (size_t)inst * DM * 4636, nullptr, P.in[I_NORM1] + inst * DM, INPROJ_FP8 ? (bf16_t*)(ws + WS_WIN + (size_t)inst * NPROJ * DM) : (bf16_t*)(ws + WS_WIN) + (size_t)inst * NPROJ * DM, 4636, XK_INPROJ, DM, kt * 64, nt * 256, INPROJ_FP8}; }
    else if (bt < BT1) { const int q = bt - BT0, inst = q / 256, r = q % 256, kt = r & 31, nt = r >> 5;
        j = XJob{P.in[I_WOUT] + (size_t)inst * DM * DM, nullptr, P.in[I_MIXG] + inst * DM, (bf16_t*)(ws + WS_WOUT) + (size_t)inst * DM * DM, DM, XK_ID, DM, kt * 64, nt * 256, 0}; }
    else if (bt < BT2) { const int q = bt - BT1, inst = q / 1408, r = q % 1408, kt = r & 31, nt = r >> 5;
        j = XJob{P.in[I_FWG] + (size_t)inst * DM * DFF, P.in[I_FWU] + (size_t)inst * DM * DFF, P.in[I_NORM2] + (2 * inst) * DM, (bf16_t*)(ws + WS_WFGU + (size_t)inst * 2 * DFF * DM), DFF, XK_GU, DM, kt * 64, nt * 256, 1}; }
    else if (bt < BT3) { const int q = bt - BT2, inst = q / 704, r = q % 704, kt = r % 88, nt = r / 88;
        j = XJob{P.in[I_FWD] + (size_t)inst * DFF * DM, nullptr, nullptr, (bf16_t*)(ws + WS_WFD + (size_t)inst * DM * DFF), DM, XK_ID, DFF, kt * 64, nt * 256, 1}; }
    else if (bt < BT4) { const int q = bt - BT3, inst = q / 896, r = q % 896, kt = r & 31, nt = r >> 5;
        j = XJob{P.in[I_MWG] + (size_t)inst * DM * DFE, P.in[I_MWU] + (size_t)inst * DM * DFE, P.in[I_NORM2] + (2 * (inst >> 3) + 1) * DM, (bf16_t*)(ws + WS_WMGU + (size_t)inst * 2 * DFE * DM), DFE, XK_GU, DM, kt * 64, nt * 256, 1}; }
    else { const int q = bt - BT4, inst = q / 448, r = q % 448, kt = r % 56, nt = r / 56;
        j = XJob{P.in[I_MWD] + (size_t)inst * DFE * DM, nullptr, nullptr, (bf16_t*)(ws + WS_WMD + (size_t)inst * DM * DFE), DM, XK_ID, DFE, kt * 64, nt * 256, 1}; }
    return j;
}
__device__ __forceinline__ void ph_prologue(LAS unsigned char* lds, const Params& P) {
    constexpr int T0 = 4 * 2432, T1 = T0 + 4 * 1024, T2 = T1 + 2 * 5632, T3 = T2 + 2 * 2816, T4 = T3 + 16 * 3584, T5 = T4 + 16 * 1792, T6 = T5 + 8 * 128, T7 = T6 + 8 * 4, T8 = T7 + 16 * 4;
    unsigned char* ws = P.ws;
    const int wid = __builtin_amdgcn_readfirstlane(otid() >> 6);
    for (int bb = obid(); bb < 256; bb += gridDim.x) {
        const int tid = otid(), inst = bb >> 5, n = (bb & 31) * 4 + (tid & 3), ks = tid >> 2;
        const float* pe = P.in[I_PE] + (size_t)inst * 4096 + ks * 32; const float* w1 = P.in[I_CW1] + (size_t)inst * 4096 * 128 + (size_t)ks * 32 * 128 + n;
        float s = 0.f;
#pragma unroll 8
        for (int k = 0; k < 32; ++k) s += pe[k] * w1[(size_t)k * 128];
        LAS float* red = (LAS float*)lds;
        red[(tid & 3) * 128 + ks] = s;
        __syncthreads();
        if (tid < 4) { float t = 0.f; for (int i = 0; i < 128; ++i) t += red[tid * 128 + i]; ((float*)(ws + WS_B1))[inst * 128 + (bb & 31) * 4 + tid] = t; }
        __syncthreads();
    }
    {
        const int lane = otid() & 63;
        auto cost = [](int it) { if (it < 512) { const int qb = it & 63; return (qb + 1) + (qb + 1 < 9 ? qb + 1 : 9) + 2 * ((4 * qb + 3 + 63) / 64) + 3; } else { const int qb = (it - 512) & 15; return 4 * (qb + 1) + 1; } };
        for (int i = obid() * 8 + wid; i < 768; i += gridDim.x * 8) {
            const int ci = cost(i); int rk = 0;
            for (int j = lane; j < 768; j += 64) { const int cj = cost(j); rk += (cj > ci || (cj == ci && j < i)) ? 1 : 0; }
#pragma unroll
            for (int o = 32; o >= 1; o >>= 1) rk += __shfl_xor(rk, o);
            if (lane == 0) ((int*)(ws + WS_ILIST))[rk] = i;
        }
    }
    {
        const int tid = otid(), lane = tid & 63; const int gs = (int)gridDim.x;
        int bt = obid(); f32x4 va[8], vb[8]; XJob ja, jb;
        if (bt < BT5) { ja = xjob(P, bt); xload(ja, wid, lane, va); }
        if (bt + gs < BT5) { jb = xjob(P, bt + gs); xload(jb, wid, lane, vb); }
        __syncthreads();
        __syncthreads();
        while (bt < BT5) {
            { XJob j = ja; xstore_lds(lds, j, wid, lane, va);
              if (bt + 2 * gs < BT5) { ja = xjob(P, bt + 2 * gs); xload(ja, wid, lane, va); }
              BAR_LDS(); xwrite_out(lds, j, tid); BAR_LDS(); }
            bt += gs; if (bt >= BT5) break;
            { XJob j = jb; xstore_lds(lds, j, wid, lane, vb);
              if (bt + 2 * gs < BT5) { jb = xjob(P, bt + 2 * gs); xload(jb, wid, lane, vb); }
              BAR_LDS(); xwrite_out(lds, j, tid); BAR_LDS(); }
            bt += gs;
        }
    }
    { const int tid = otid();
      for (int ch = obid() * 512 + tid; ch < 8 * 32 * 4 * 8 * 64; ch += gridDim.x * 512) {
          const int ln = ch & 63, dd = (ch >> 6) & 7, nb = (ch >> 9) & 3, l = (ch >> 11) & 31, inst = ch >> 16;
          const float* src = P.in[I_CW1] + ((size_t)inst * 4096 + l * 128 + dd * 16 + (ln >> 5) * 8) * 128 + nb * 32 + (ln & 31);
          float v[8];
#pragma unroll
          for (int e = 0; e < 8; ++e) v[e] = src[(size_t)e * 128];
          u32x4 w; w.x = pg8::cvt_pk_bf16(v[0], v[1]); w.y = pg8::cvt_pk_bf16(v[2], v[3]); w.z = pg8::cvt_pk_bf16(v[4], v[5]); w.w = pg8::cvt_pk_bf16(v[6], v[7]);
          ((u32x4*)(ws + WS_WC1))[ch] = w; } }
    { const int tid = otid();
      for (int ch = obid() * 512 + tid; ch < 16 * 4 * 8 * 64; ch += gridDim.x * 512) {
          const int ln = ch & 63, d0 = (ch >> 6) & 7, nb = (ch >> 9) & 3, inst = ch >> 11;
          const float* src = P.in[I_POOLW] + ((size_t)inst * 128 + d0 * 16 + (ln >> 5) * 8) * 128 + nb * 32 + (ln & 31);
          float v[8];
#pragma unroll
          for (int e = 0; e < 8; ++e) v[e] = src[(size_t)e * 128];
          u32x4 w; w.x = pg8::cvt_pk_bf16(v[0], v[1]); w.y = pg8::cvt_pk_bf16(v[2], v[3]); w.z = pg8::cvt_pk_bf16(v[4], v[5]); w.w = pg8::cvt_pk_bf16(v[6], v[7]);
          ((u32x4*)(ws + WS_WPOOL))[ch] = w; } }
    for (int tix = T5 + obid() * 8 + wid; tix < T8; tix += gridDim.x * 8) {
        if (false) {}
        else if (tix < T6) { }
        else if (tix < T7) { const int q = tix - T6, inst = q / 4, r = q % 4, kt = r / 2, nt = r % 2;
            xpose_tile(P.in[I_CW2] + (size_t)inst * 128 * 128, nullptr, 128, XK_ID, nullptr, (bf16_t*)(ws + WS_WC2) + (size_t)inst * 128 * 128, 128, kt * 64, nt * 64); }
        else { }
    }
}

#ifndef NRW
#define NRW 4
#endif
template <int MODE, bool XS = false>
__device__ __forceinline__ void ph_norm(LAS unsigned char* lds, const Params& P, const float* xsrc  , bf16_t* xb16  , bool combine, const float* gain, const float* router, float* outp, bool out8 = false) {
    const int tid = otid(), wid = __builtin_amdgcn_readfirstlane(tid >> 6), lane = tid & 63;
    constexpr int NR_ = (XS || MODE == 1) ? 2 : NRW;
    bf16_t* hb = (bf16_t*)(P.ws + WS_H);
    int* route = (int*)(P.ws + WS_ROUTE);
    const unsigned char* Y8 = (const unsigned char*)(P.ws + WS_MIX);
    LAS float* RT = (LAS float*)lds;
    LAS int* EL = (LAS int*)(lds + 65536);
    if (MODE == 1) { for (int i = tid; i < DM * 8 / 4; i += 512) ((LAS f32x4*)RT)[i] = ((const f32x4*)router)[i]; __syncthreads(); }
    f32x4 gfin[8];
    if (MODE == 2) {
#pragma unroll
        for (int j = 0; j < 8; ++j) gfin[j] = *(const f32x4*)(gain + j * 256 + lane * 4); }
    for (int rb = obid(); rb < NT / 64; rb += gridDim.x) {
        for (int s0 = 0; s0 < 8; s0 += NR_) {
            f32x4 xf[XS ? NR_ : 1][8]; u32x2 xr[XS ? 1 : NR_][8]; unsigned ya[NR_][8], yc[NR_][8]; int sl1[NR_], sl2[NR_]; float cw1[NR_], cw2[NR_];
#pragma unroll
            for (int q = 0; q < NR_; ++q) { const int row = rb * 64 + (s0 + q) * 8 + wid;
#pragma unroll
                for (int j = 0; j < 8; ++j) {
                    if (XS) xf[XS ? q : 0][j] = *(const f32x4*)(xsrc + (size_t)row * DM + j * 256 + lane * 4);
                    else xr[XS ? 0 : q][j] = *(const u32x2*)(xb16 + (size_t)row * DM + j * 256 + lane * 4); }
                if (combine) { sl1[q] = route[row * 8 + 4]; sl2[q] = route[row * 8 + 5]; cw1[q] = __int_as_float(route[row * 8 + 2]); cw2[q] = __int_as_float(route[row * 8 + 3]); } }
            if (combine) {
#pragma unroll
                for (int q = 0; q < NR_; ++q)
#pragma unroll
                    for (int j = 0; j < 8; ++j) { ya[q][j] = *(const unsigned*)(Y8 + (size_t)sl1[q] * DM + j * 256 + lane * 4); yc[q][j] = *(const unsigned*)(Y8 + (size_t)sl2[q] * DM + j * 256 + lane * 4); } }
#pragma unroll
          for (int q = 0; q < NR_; ++q) {
            const int s = s0 + q;
            const int row = rb * 64 + s * 8 + wid;
            f32x4 xv[8];
#pragma unroll
            for (int j = 0; j < 8; ++j) {
                if (XS) xv[j] = xf[XS ? q : 0][j];
                else { const u32x2 w = xr[XS ? 0 : q][j];
                    xv[j] = (f32x4){__uint_as_float(w.x << 16), __uint_as_float(w.x & 0xffff0000u), __uint_as_float(w.y << 16), __uint_as_float(w.y & 0xffff0000u)}; } }
            if (combine) {
                const float w1 = cw1[q], w2 = cw2[q];
#pragma unroll
                for (int j = 0; j < 8; ++j) { const unsigned a = ya[q][j], c = yc[q][j];
                    const f32x2 a0 = __builtin_amdgcn_cvt_pk_f32_fp8(a, false), a1 = __builtin_amdgcn_cvt_pk_f32_fp8(a, true), c0 = __builtin_amdgcn_cvt_pk_f32_fp8(c, false), c1 = __builtin_amdgcn_cvt_pk_f32_fp8(c, true);
                    xv[j][0] += w1 * a0[0] + w2 * c0[0]; xv[j][1] += w1 * a0[1] + w2 * c0[1]; xv[j][2] += w1 * a1[0] + w2 * c1[0]; xv[j][3] += w1 * a1[1] + w2 * c1[1]; }
                if (MODE != 2) {
#pragma unroll
                    for (int j = 0; j < 8; ++j) { u32x2 w; w.x = pg8::cvt_pk_bf16(xv[j][0], xv[j][1]); w.y = pg8::cvt_pk_bf16(xv[j][2], xv[j][3]); *(u32x2*)(xb16 + (size_t)row * DM + j * 256 + lane * 4) = w; } }
            }
            float ss = 0.f;
#pragma unroll
            for (int j = 0; j < 8; ++j) ss += (xv[j][0] * xv[j][0] + xv[j][1] * xv[j][1]) + (xv[j][2] * xv[j][2] + xv[j][3] * xv[j][3]);
#pragma unroll
            for (int o = 32; o >= 1; o >>= 1) ss += __shfl_xor(ss, o);
            const float rstd = 1.0f / sqrtf(ss * (1.0f / DM) + 1e-6f);
            if (MODE == 2) {
#pragma unroll
                for (int j = 0; j < 8; ++j) *(f32x4*)(outp + (size_t)row * DM + j * 256 + lane * 4) = xv[j] * rstd * gfin[j];
            } else {
#pragma unroll
                for (int j = 0; j < 8; ++j) {
                    if (out8) *(unsigned*)((unsigned char*)hb + (size_t)row * DM + j * 256 + lane * 4) = pg8::pack_fp8x4(xv[j][0] * rstd, xv[j][1] * rstd, xv[j][2] * rstd, xv[j][3] * rstd);
                    else { u32x2 w; w.x = pg8::cvt_pk_bf16(xv[j][0] * rstd, xv[j][1] * rstd); w.y = pg8::cvt_pk_bf16(xv[j][2] * rstd, xv[j][3] * rstd);
                        *(u32x2*)(hb + (size_t)row * DM + j * 256 + lane * 4) = w; } }
            }
            if (MODE == 1) {
                float lg[8];
#pragma unroll
                for (int e = 0; e < 8; ++e) lg[e] = 0.f;
#pragma unroll
                for (int j = 0; j < 8; ++j) { const f32x4 gv = *(const f32x4*)(gain + j * 256 + lane * 4);
#pragma unroll
                    for (int i = 0; i < 4; ++i) { const float hn = xv[j][i] * rstd * gv[i]; const int k = j * 256 + lane * 4 + i;
                        const f32x4 r0 = *(LAS const f32x4*)(RT + k * 8), r1 = *(LAS const f32x4*)(RT + k * 8 + 4);
                        lg[0] += hn * r0[0]; lg[1] += hn * r0[1]; lg[2] += hn * r0[2]; lg[3] += hn * r0[3]; lg[4] += hn * r1[0]; lg[5] += hn * r1[1]; lg[6] += hn * r1[2]; lg[7] += hn * r1[3]; } }
#pragma unroll
                for (int e = 0; e < 8; ++e) {
#pragma unroll
                    for (int o = 32; o >= 1; o >>= 1) lg[e] += __shfl_xor(lg[e], o); }
                if (lane == 0) {
                    int e1 = 0; float v1 = lg[0];
#pragma unroll
                    for (int e = 1; e < 8; ++e) if (lg[e] > v1) { v1 = lg[e]; e1 = e; }
                    int e2 = -1; float v2 = -3.0e38f;
#pragma unroll
                    for (int e = 0; e < 8; ++e) if (e != e1 && lg[e] > v2) { v2 = lg[e]; e2 = e; }
                    if (e2 < 0) { e2 = (e1 + 1) & 7; v2 = v1; }
                    const float ex = __expf(v2 - v1), w1 = 1.0f / (1.0f + ex), w2 = ex / (1.0f + ex);
                    route[row * 8 + 0] = e1; route[row * 8 + 1] = e2; route[row * 8 + 2] = __float_as_int(w1); route[row * 8 + 3] = __float_as_int(w2);
                    EL[(s * 8 + wid) * 2] = e1; EL[(s * 8 + wid) * 2 + 1] = e2;
                }
            }
        }
          }
        if (MODE == 1) {
            __syncthreads();
            if (tid < 8) { int c = 0; for (int i = 0; i < 128; ++i) c += (EL[i] == tid) ? 1 : 0; ((int*)(P.ws + WS_HIST))[rb * 8 + tid] = c; }
            __syncthreads();
        }
    }
}

__device__ __forceinline__ void ph_moe_gather(LAS unsigned char* lds, const Params& P) {
    const int tid = otid(), wid = __builtin_amdgcn_readfirstlane(tid >> 6), lane = tid & 63;
    const int* hist = (const int*)(P.ws + WS_HIST); int* route = (int*)(P.ws + WS_ROUTE); int* tab = (int*)(P.ws + WS_TAB);
    int* rowtok = (int*)(P.ws + WS_ROWTOK);
    LAS int* RED = (LAS int*)lds;
    LAS int* TOT = RED + 1024;
    LAS int* ELS = TOT + 64;
    for (int rb = obid(); rb < NT / 64; rb += gridDim.x) {
        { const int e = tid & 7, part = tid >> 3; int sa = 0, sb = 0;
          for (int b2 = part; b2 < 256; b2 += 64) { const int v = hist[b2 * 8 + e]; sa += v; if (b2 < rb) sb += v; }
          RED[part * 8 + e] = sa; RED[512 + part * 8 + e] = sb; }
        __syncthreads();
        if (tid < 8) { int sa = 0, sb = 0; for (int p2 = 0; p2 < 64; ++p2) { sa += RED[p2 * 8 + tid]; sb += RED[512 + p2 * 8 + tid]; } TOT[tid] = sa; TOT[8 + tid] = sb; }
        __syncthreads();
        if (tid == 0) { int acc = 0; for (int e = 0; e < 8; ++e) { TOT[16 + e] = acc; TOT[32 + e] = acc * 256 + TOT[8 + e]; acc += (TOT[e] + 255) >> 8; } TOT[24] = acc;
            if (rb == 0) { for (int e = 0; e <= 8; ++e) tab[e] = TOT[16 + e]; } }
        if (tid < 128) ELS[tid] = route[(rb * 64 + (tid >> 1)) * 8 + (tid & 1)];
        __syncthreads();
        if (tid < 128) { const int e = ELS[tid]; int rk = 0; for (int i = 0; i < tid; ++i) rk += (ELS[i] == e) ? 1 : 0;
            const int slot = TOT[32 + e] + rk; ELS[128 + tid] = slot; route[(rb * 64 + (tid >> 1)) * 8 + 4 + (tid & 1)] = slot; }
        __syncthreads();
        if (tid < 128) rowtok[ELS[128 + tid]] = rb * 64 + (tid >> 1);
        for (int e = 0; e < 8; ++e) { const int r0 = TOT[16 + e] * 256 + TOT[e], r1 = TOT[16 + e + 1] * 256;
            for (int r = r0 + rb * 512 + tid; r < r1; r += 512 * 256) rowtok[r] = 0; }
        __syncthreads();
    }
}

#ifndef MIXNR
#define MIXNR 4
#endif
__device__ __forceinline__ void ph_mixnorm(const Params& P) {
    const int tid = otid(), wid = __builtin_amdgcn_readfirstlane(tid >> 6), lane = tid & 63;
    const bf16_t* mix = (const bf16_t*)(P.ws + WS_MIX); bf16_t* hb = (bf16_t*)(P.ws + WS_H);
    for (int row0 = obid() * 8 + wid; row0 < NT; row0 += gridDim.x * 8 * MIXNR) {
        u32x2 rc0[MIXNR][4], rc1[MIXNR][4], rc2[MIXNR][4]; u32x4 rpw[MIXNR], rcw[MIXNR];
#pragma unroll
        for (int q = 0; q < MIXNR; ++q) { const int row = row0 + q * gridDim.x * 8;
            if (row < NT) { const bf16_t* mr = mix + (size_t)row * 4096;
#pragma unroll
                for (int j = 0; j < 4; ++j) { rc0[q][j] = *(const u32x2*)(mr + j * 256 + lane * 4); rc1[q][j] = *(const u32x2*)(mr + 1024 + j * 256 + lane * 4); rc2[q][j] = *(const u32x2*)(mr + 2048 + j * 256 + lane * 4); }
                rpw[q] = *(const u32x4*)(mr + 3072 + lane * 8); rcw[q] = *(const u32x4*)(mr + 3584 + lane * 8); } }
#pragma unroll
        for (int q = 0; q < MIXNR; ++q) { const int row = row0 + q * gridDim.x * 8;
          if (row < NT) {
            float av[4][4], pv[8], cv[8];
            float sa = 0.f, sp = 0.f, sc = 0.f;
#pragma unroll
            for (int j = 0; j < 4; ++j) { const u32x2 c0 = rc0[q][j], c1 = rc1[q][j], c2 = rc2[q][j];
                av[j][0] = (__uint_as_float(c0.x << 16) + __uint_as_float(c1.x << 16)) + __uint_as_float(c2.x << 16);
                av[j][1] = (__uint_as_float(c0.x & 0xffff0000u) + __uint_as_float(c1.x & 0xffff0000u)) + __uint_as_float(c2.x & 0xffff0000u);
                av[j][2] = (__uint_as_float(c0.y << 16) + __uint_as_float(c1.y << 16)) + __uint_as_float(c2.y << 16);
                av[j][3] = (__uint_as_float(c0.y & 0xffff0000u) + __uint_as_float(c1.y & 0xffff0000u)) + __uint_as_float(c2.y & 0xffff0000u);
                sa += (av[j][0] * av[j][0] + av[j][1] * av[j][1]) + (av[j][2] * av[j][2] + av[j][3] * av[j][3]); }
            { const u32x4 pw = rpw[q], cw = rcw[q];
              const unsigned pa[4] = {pw.x, pw.y, pw.z, pw.w}, ca[4] = {cw.x, cw.y, cw.z, cw.w};
#pragma unroll
              for (int i = 0; i < 4; ++i) { pv[2 * i] = __uint_as_float(pa[i] << 16); pv[2 * i + 1] = __uint_as_float(pa[i] & 0xffff0000u); cv[2 * i] = __uint_as_float(ca[i] << 16); cv[2 * i + 1] = __uint_as_float(ca[i] & 0xffff0000u);
                  sp += pv[2 * i] * pv[2 * i] + pv[2 * i + 1] * pv[2 * i + 1]; sc += cv[2 * i] * cv[2 * i] + cv[2 * i + 1] * cv[2 * i + 1]; } }
#pragma unroll
            for (int o = 32; o >= 1; o >>= 1) { sa += __shfl_xor(sa, o); sp += __shfl_xor(sp, o); sc += __shfl_xor(sc, o); }
            const float ra = 1.0f / sqrtf(sa * (1.0f / 1024.f) + 1e-6f), rp = 1.0f / sqrtf(sp * (1.0f / 512.f) + 1e-6f), rc = 1.0f / sqrtf(sc * (1.0f / 512.f) + 1e-6f);
            bf16_t* hr = hb + (size_t)row * DM;
#pragma unroll
            for (int j = 0; j < 4; ++j) { u32x2 w; w.x = pg8::cvt_pk_bf16(av[j][0] * ra, av[j][1] * ra); w.y = pg8::cvt_pk_bf16(av[j][2] * ra, av[j][3] * ra); *(u32x2*)(hr + j * 256 + lane * 4) = w; }
            { u32x4 w; w.x = pg8::cvt_pk_bf16(pv[0] * rp, pv[1] * rp); w.y = pg8::cvt_pk_bf16(pv[2] * rp, pv[3] * rp); w.z = pg8::cvt_pk_bf16(pv[4] * rp, pv[5] * rp); w.w = pg8::cvt_pk_bf16(pv[6] * rp, pv[7] * rp); *(u32x4*)(hr + 1024 + lane * 8) = w; }
            { u32x4 w; w.x = pg8::cvt_pk_bf16(cv[0] * rc, cv[1] * rc); w.y = pg8::cvt_pk_bf16(cv[2] * rc, cv[3] * rc); w.z = pg8::cvt_pk_bf16(cv[4] * rc, cv[5] * rc); w.w = pg8::cvt_pk_bf16(cv[6] * rc, cv[7] * rc); *(u32x4*)(hr + 1536 + lane * 8) = w; }
          } }
    }
}

constexpr int POOL_PITCH = 272, POOL_SLAB = 48 * POOL_PITCH;
__device__ __forceinline__ float gelu_tanh(float x) { const float u = 0.7978845608028654f * (x + 0.044715f * x * x * x); const float e = __expf(2.0f * u); const float th = 1.0f - 2.0f / (e + 1.0f); return 0.5f * x * (1.0f + th); }
__device__ __forceinline__ void compress_item(LAS unsigned char* lds, const Params& P, int layer, int item) {
    const int tid = otid(), wid = __builtin_amdgcn_readfirstlane(tid >> 6), lane = tid & 63, r32 = lane & 31, hi = lane >> 5;
    const int j = item & 1, bg = (item >> 1) & 7, rb = item >> 4, b = bg >> 1, g = bg & 1;
    const bf16_t* proj = (const bf16_t*)(P.ws + WS_PROJ);
    const bf16_t* w2t = (const bf16_t*)(P.ws + WS_WC2) + (size_t)(layer * 2 + j) * 128 * 128;
    const float* b1 = (const float*)(P.ws + WS_B1) + (layer * 2 + j) * 128;
    bf16_t* kc = (bf16_t*)(P.ws + WS_KC) + (size_t)(j * 8 + bg) * 256 * 128;
    LAS float* RED = (LAS float*)lds;
    LAS bf16_t* HID = (LAS bf16_t*)(lds + 32768);
    const int nb = wid & 3, kh = wid >> 2, c = rb * 32 + r32;
    const int colbase = PC_KC + j * 256 + g * 128;
    f32x16 acc;
#pragma unroll
    for (int r = 0; r < 16; ++r) acc[r] = 0.f;
    {
        LAS unsigned char* slab = lds + 49152 + wid * (32 * POOL_PITCH);
        const u32x4* w1f = (const u32x4*)(P.ws + WS_WC1) + (size_t)(layer * 2 + j) * 32 * 4 * 8 * 64;
        const int rsub = lane >> 4, ch = lane & 15;
        bf16x8 st[8], fb[8];
#define CMP_GLOAD(l_) do { _Pragma("unroll") for (int it = 0; it < 8; ++it) { int tok_ = 16 * (rb * 32 + it * 4 + rsub) + (l_); tok_ = tok_ > SEQ - 1 ? SEQ - 1 : tok_; \
            st[it] = *(const bf16x8*)(proj + ((size_t)b * SEQ + tok_) * NPROJ + colbase + ch * 8); } } while (0)
#define CMP_BLOAD(l_) do { _Pragma("unroll") for (int dd = 0; dd < 8; ++dd) fb[dd] = __builtin_bit_cast(bf16x8, w1f[(((l_) * 4 + nb) * 8 + dd) * 64 + lane]); } while (0)
        const int l0 = 16 * kh;
        CMP_GLOAD(l0);
        for (int l = l0; l < l0 + 16; ++l) {
#pragma unroll
            for (int it = 0; it < 8; ++it) *(LAS bf16x8*)(slab + (it * 4 + rsub) * POOL_PITCH + ch * 16) = st[it];
            CMP_BLOAD(l);
            if (l + 1 < l0 + 16) CMP_GLOAD(l + 1);
            asm volatile("s_waitcnt lgkmcnt(0)" ::: "memory");
            bf16x8 fa[8];
#pragma unroll
            for (int dd = 0; dd < 8; ++dd) fa[dd] = *(LAS const bf16x8*)(slab + r32 * POOL_PITCH + (dd * 2 + hi) * 16);
#pragma unroll
            for (int dd = 0; dd < 8; ++dd) acc = __builtin_amdgcn_mfma_f32_32x32x16_bf16(fa[dd], fb[dd], acc, 0, 0, 0);
        }
#undef CMP_GLOAD
#undef CMP_BLOAD
    }
#pragma unroll
    for (int r = 0; r < 16; ++r) RED[(kh * 32 + at::crow(r, hi)) * 128 + nb * 32 + r32] = acc[r];
    __syncthreads();
#pragma unroll
    for (int i = 0; i < 8; ++i) { const int idx = tid + 512 * i, row = idx >> 7, n = idx & 127;
        const float v = gelu_tanh((RED[row * 128 + n] + RED[(32 + row) * 128 + n]) + b1[n]);
        unsigned u = __float_as_uint(v); u += 0x7FFFu + ((u >> 16) & 1u);
        HID[row * 136 + n] = (bf16_t)(u >> 16); }
    __syncthreads();
    if (wid < 4) {
        f32x16 a2;
#pragma unroll
        for (int r = 0; r < 16; ++r) a2[r] = 0.f;
        bf16x8 ha[8], hbv[8];
#pragma unroll
        for (int dd = 0; dd < 8; ++dd) { ha[dd] = *(LAS const bf16x8*)(HID + r32 * 136 + dd * 16 + hi * 8); hbv[dd] = *(const bf16x8*)(w2t + (size_t)(wid * 32 + r32) * 128 + dd * 16 + hi * 8); }
        __builtin_amdgcn_sched_barrier(0);
#pragma unroll
        for (int dd = 0; dd < 8; ++dd) a2 = __builtin_amdgcn_mfma_f32_32x32x16_bf16(ha[dd], hbv[dd], a2, 0, 0, 0);
#pragma unroll
        for (int r = 0; r < 16; ++r) { unsigned u = __float_as_uint(a2[r]); u += 0x7FFFu + ((u >> 16) & 1u);
            kc[(size_t)(rb * 32 + at::crow(r, hi)) * 128 + wid * 32 + r32] = (bf16_t)(u >> 16); }
    }
    __syncthreads();
}

__device__ __forceinline__ void cumsum_item(LAS unsigned char* lds, const Params& P, int layer, int bh) {
    const int tid = otid(), wid = __builtin_amdgcn_readfirstlane(tid >> 6), lane = tid & 63;
    const int b = bh >> 2, h = bh & 3;
    const float* gf = (const float*)(P.ws + WS_GF); float* cum = (float*)(P.ws + WS_CUM) + (size_t)bh * SEQ;
    const float fb = P.in[I_FB][layer * 4 + h];
    LAS float* WS = (LAS float*)lds;
    float v[8]; float run = 0.f;
#pragma unroll
    for (int i = 0; i < 8; ++i) { const float z = gf[((size_t)b * SEQ + tid * 8 + i) * 32 + 24 + h] + fb;
        const float ls = fminf(z, 0.f) - log1pf(__expf(-fabsf(z))); run += ls; v[i] = run; }
    float sc = run;
#pragma unroll
    for (int o = 1; o < 64; o <<= 1) { const float t = __shfl_up(sc, o); if (lane >= o) sc += t; }
    if (lane == 63) WS[wid] = sc;
    __syncthreads();
    float base = sc - run;
    for (int w = 0; w < wid; ++w) base += WS[w];
#pragma unroll
    for (int i = 0; i < 8; ++i) cum[tid * 8 + i] = (base + v[i]) * LOG2E;
    __syncthreads();
}

__device__ __forceinline__ void knorm_item(const Params& P, int witem) {
    const int lane = otid() & 63, rsub = lane >> 4, ch = lane & 15;
    const int bh = witem >> 6, T = witem & 63, b = bh >> 2, h = bh & 3;
    const bf16_t* kp = (const bf16_t*)(P.ws + WS_PROJ) + ((size_t)b * SEQ + T * 64 + rsub) * NPROJ + PC_FK + h * 128 + ch * 8;
    bf16x8 kv[16];
#pragma unroll
    for (int it = 0; it < 16; ++it) kv[it] = *(const bf16x8*)(kp + (size_t)(it * 4) * NPROJ);
    float mx = 0.f;
#pragma unroll
    for (int it = 0; it < 16; ++it) { float ss = 0.f;
#pragma unroll
        for (int e = 0; e < 8; ++e) { const float x = bf2f((bf16_t)kv[it][e]); ss += x * x; }
        ss += __shfl_xor(ss, 1); ss += __shfl_xor(ss, 2); ss += __shfl_xor(ss, 4); ss += __shfl_xor(ss, 8);
        mx = fmaxf(mx, ss); }
    mx = fmaxf(mx, __shfl_xor(mx, 16)); mx = fmaxf(mx, __shfl_xor(mx, 32));
    if (lane == 0) ((float*)(P.ws + WS_KSG))[bh * 64 + T] = sqrtf(mx);
}

__device__ __forceinline__ void pool_item(LAS unsigned char* lds, const Params& P, int layer, int witem) {
    const int tid = otid(), wid = __builtin_amdgcn_readfirstlane(tid >> 6), lane = tid & 63, r32 = lane & 31, hi = lane >> 5;
    const int gi = witem & 3, tb = witem >> 2;
    const int w = 2 << gi;
    const bf16_t* proj = (const bf16_t*)(P.ws + WS_PROJ); bf16_t* mix = (bf16_t*)(P.ws + WS_MIX);
    const u32x4* pwf = (const u32x4*)(P.ws + WS_WPOOL) + (size_t)(layer * 4 + gi) * 4 * 8 * 64;
    const float* psc = P.in[I_POOLS] + layer * 512 + gi * 128;
    LAS unsigned char* slab = lds + wid * POOL_SLAB;
    const int t0 = tb * 32, s0 = t0 & (SEQ - 1);
    { const int rsub = lane >> 4, ch = lane & 15;
#pragma unroll
      for (int it = 0; it < 12; ++it) { const int i = it * 4 + rsub; const int tok = t0 - 16 + i;
          if (s0 - 16 + i >= 0) { const bf16x8 v = *(const bf16x8*)(proj + (size_t)tok * NPROJ + PC_POOL + gi * 128 + ch * 8);
              *(LAS bf16x8*)(slab + i * POOL_PITCH + ch * 16) = v; } } }
    asm volatile("s_waitcnt lgkmcnt(0)" ::: "memory");
    const int s = s0 + r32;
    const int n = (s + 1) < w ? (s + 1) : w;
    const float invn = 1.0f / (float)n;
    bf16x8 afr[8];
#pragma unroll
    for (int d0 = 0; d0 < 8; ++d0) {
        LAS const unsigned char* up = slab + (16 + r32) * POOL_PITCH + (d0 * 2 + hi) * 16;
        float sum[8], cur[8];
        { const bf16x8 v = *(LAS const bf16x8*)up;
#pragma unroll
          for (int i = 0; i < 8; ++i) { cur[i] = bf2f((bf16_t)v[i]); sum[i] = cur[i]; } }
        for (int k = 1; k < n; ++k) { const bf16x8 v = *(LAS const bf16x8*)(up - k * POOL_PITCH);
#pragma unroll
            for (int i = 0; i < 8; ++i) sum[i] += bf2f((bf16_t)v[i]); }
        u32x4 wv;
        wv.x = pg8::cvt_pk_bf16(sum[0] * invn - cur[0], sum[1] * invn - cur[1]); wv.y = pg8::cvt_pk_bf16(sum[2] * invn - cur[2], sum[3] * invn - cur[3]);
        wv.z = pg8::cvt_pk_bf16(sum[4] * invn - cur[4], sum[5] * invn - cur[5]); wv.w = pg8::cvt_pk_bf16(sum[6] * invn - cur[6], sum[7] * invn - cur[7]);
        afr[d0] = *reinterpret_cast<bf16x8*>(&wv);
    }
#pragma unroll
    for (int nb = 0; nb < 4; ++nb) {
        f32x16 acc;
#pragma unroll
        for (int r = 0; r < 16; ++r) acc[r] = 0.f;
        bf16x8 bfr[8];
#pragma unroll
        for (int d0 = 0; d0 < 8; ++d0) bfr[d0] = __builtin_bit_cast(bf16x8, pwf[(nb * 8 + d0) * 64 + lane]);
        __builtin_amdgcn_sched_barrier(0);
#pragma unroll
        for (int d0 = 0; d0 < 8; ++d0) acc = __builtin_amdgcn_mfma_f32_32x32x16_bf16(afr[d0], bfr[d0], acc, 0, 0, 0);
        const float sc = psc[nb * 32 + r32];
#pragma unroll
        for (int r = 0; r < 16; ++r) { const float v = acc[r] * sc;
            const float vn = __int_as_float(__builtin_amdgcn_update_dpp(0, __float_as_int(v), 0xB1, 0xF, 0xF, true));
            if ((r32 & 1) == 0) *(unsigned*)(mix + (size_t)(tb * 32 + at::crow(r, hi)) * 4096 + 3072 + gi * 128 + nb * 32 + r32) = pg8::cvt_pk_bf16(v, vn); }
    }
}

constexpr int NPL = 10, NPH = 1 + DEPTH * NPL + 1;
constexpr int LDS_MISC = 131072, LDS_BYTES = LDS_MISC + 256;

__global__ void __launch_bounds__(512, 2) hymba_fwd(Params P) {
    extern __shared__ __attribute__((aligned(16))) unsigned char shm[];
    LAS unsigned char* lds = (LAS unsigned char*)shm;
    volatile LAS unsigned* MISC = (volatile LAS unsigned*)(lds + LDS_MISC);
    const int tid = otid(), wid = __builtin_amdgcn_readfirstlane(tid >> 6);
    const int G = gridDim.x, lo = P.ph_lo, hi = P.ph_hi;
    if (tid == 0) { MISC[0] = 0u; MISC[1] = 0u; MISC[2] = 0u; MISC[3] = 0u; }
    __syncthreads();
    unsigned char* ws = P.ws;
    XcdBarrier bar; bar.bar = (unsigned*)(ws + WS_CTL); bar.x = 0; bar.st = MISC;
    if (hi - lo > 1) bar = xcd_barrier_post((unsigned*)(ws + WS_CTL), MISC);
#define IN(k) (lo <= (k) && (k) < hi)
#define BAR_AFTER(k) do { if (IN(k) && (k) + 1 < hi) xcd_barrier(bar); } while (0)
    const float* x_in = P.in[I_X];
    bf16_t* xb = (bf16_t*)(ws + WS_X); bf16_t* hb = (bf16_t*)(ws + WS_H); bf16_t* proj = (bf16_t*)(ws + WS_PROJ); float* gf = (float*)(ws + WS_GF);
    bf16_t* act = (bf16_t*)(ws + WS_ACT); const int* tab = (const int*)(ws + WS_TAB);

    if (IN(0) && (PHM & 1)) for (int rep_ = 0; rep_ < ((REPM & 1) ? 2 : 1); ++rep_) { ph_prologue(lds, P); ph_norm<0, true>(lds, P, x_in, xb, false, nullptr, nullptr, nullptr, INPROJ_FP8 != 0); }
    BAR_AFTER(0);
    for (int l = 0; l < DEPTH; ++l) {
        const int pb = 1 + l * NPL, i2 = l >> 1; const bool moe = (l & 1) != 0;
        if (l > 0) {
        if (IN(pb + 0) && (PHM & 2)) for (int rep_ = 0; rep_ < (((REPM & 2) && l != 2) ? 2 : 1); ++rep_) ph_norm<0>(lds, P, nullptr, xb, l == 2, nullptr, nullptr, nullptr, INPROJ_FP8 != 0);
        BAR_AFTER(pb + 0);
        }
        if (IN(pb + 1) && (PHM & 4)) for (int rep_ = 0; rep_ < ((REPM & 4) ? 2 : 1); ++rep_) { pg8::StaticOrder S; S.init(NT, NPROJ, G, obid(), WGM_INPROJ);
#if INPROJ_FP8
            pg8::Gemm g{hb  , (const bf16_t*)(ws + WS_WIN + (size_t)l * NPROJ * DM), NT, NPROJ, DM / 2  , nullptr};
            pg8::EpiProj E{proj, gf, 1.0f / WSCALE8}; pg8::gemm_phase<pg8::EpiProj, pg8::StaticOrder, false, true>(lds, g, S, E); }
#else
            pg8::Gemm g{hb, (const bf16_t*)(ws + WS_WIN) + (size_t)l * NPROJ * DM, NT, NPROJ, DM, nullptr};
            pg8::EpiProj E{proj, gf, 1.0f}; pg8::gemm_phase<pg8::EpiProj, pg8::StaticOrder>(lds, g, S, E); }
#endif
        BAR_AFTER(pb + 1);
        if (IN(pb + 2) && (PHM & 8)) for (int rep_ = 0; rep_ < ((REPM & 8) ? 2 : 1); ++rep_) {
            for (int it = obid(); it < 128; it += G) compress_item(lds, P, l, it);
            for (int it = obid() - 128; it < 16; it += G) if (it >= 0) cumsum_item(lds, P, l, it);
            { unsigned* pcnt = (unsigned*)(ws + WS_CTL) + 8192 + 64 * (l * 2 + rep_);
              for (;;) { int it = 0; if ((otid() & 63) == 0) it = (int)__hip_atomic_fetch_add(pcnt, 1u, __ATOMIC_RELAXED, __HIP_MEMORY_SCOPE_AGENT);
                  it = __builtin_amdgcn_readfirstlane(it);
                  if (it >= 3072) break;
                  if (it < 1024) knorm_item(P, it); else pool_item(lds, P, l, it - 1024); } }
        }
        BAR_AFTER(pb + 2);
        if (IN(pb + 3) && (PHM & 16)) for (int rep_ = 0; rep_ < ((REPM & 16) ? 2 : 1); ++rep_) {
            unsigned* qcnt = (unsigned*)(ws + WS_CTL) + 4096 + 64 * (l * 2 + rep_);
            const int* ilist = (const int*)(ws + WS_ILIST);
            LAS int* QI = (LAS int*)(lds + at::OFF_Q);
            for (;;) {
                if (otid() == 0) QI[0] = (int)__hip_atomic_fetch_add(qcnt, 1u, __ATOMIC_RELAXED, __HIP_MEMORY_SCOPE_AGENT);
                __syncthreads();
                const int qi_ = QI[0];
                __syncthreads();
                if (qi_ >= 768) break;
                const int it = ilist[qi_];
                if (it < 512) nsa_item((LAS char*)lds, P, it >> 6, it & 63);
                else fox_item((LAS char*)lds, P, (it - 512) >> 4, (it - 512) & 15);
            }
        }
        BAR_AFTER(pb + 3);
        if (IN(pb + 4) && (PHM & 32)) for (int rep_ = 0; rep_ < ((REPM & 32) ? 2 : 1); ++rep_) ph_mixnorm(P);
        BAR_AFTER(pb + 4);
        if (IN(pb + 5) && (PHM & 64)) for (int rep_ = ((REPM & 64) ? 1 : 0); rep_ >= 0; --rep_) { pg8::Gemm g{hb, (const bf16_t*)(ws + WS_WOUT) + (size_t)l * DM * DM, NT, DM, DM, nullptr}; pg8::StaticOrder S; S.init(NT, DM, G, obid(), WGM_OUT);
            pg8::EpiResB E{l == 0 ? (const void*)x_in : (const void*)xb, l == 0 ? 1 : 0, rep_ ? (bf16_t*)(ws + WS_ACT) : xb, 1.0f}; pg8::gemm_phase<pg8::EpiResB, pg8::StaticOrder>(lds, g, S, E); }
        BAR_AFTER(pb + 5);
        if (IN(pb + 6) && (PHM & 128)) { if (moe) ph_norm<1>(lds, P, nullptr, xb, false, P.in[I_NORM2] + l * DM, P.in[I_ROUTER] + (size_t)i2 * DM * 8, nullptr, true);
                          else ph_norm<0>(lds, P, nullptr, xb, false, nullptr, nullptr, nullptr, true); }
        BAR_AFTER(pb + 6);
        if (moe) {
            if (IN(pb + 7) && (PHM & 256)) ph_moe_gather(lds, P);
            BAR_AFTER(pb + 7);
            if (IN(pb + 8) && (PHM & 512)) for (int rep_ = 0; rep_ < ((REPM & 512) ? 2 : 1); ++rep_) { pg8::Gemm g{hb  , (const bf16_t*)(ws + WS_WMGU + (size_t)i2 * 8 * 2 * DFE * DM), 0, 2 * DFE, DM / 2  , (const int*)(ws + WS_ROWTOK)}; pg8::GroupedOrder S; S.initg(tab, 2 * DFE, G, obid(), WGM_MUP);
                pg8::EpiSwiglu8 E{(unsigned char*)act, DFE, 1.0f / WSCALE8}; pg8::gemm_phase<pg8::EpiSwiglu8, pg8::GroupedOrder, true, true>(lds, g, S, E); }
            BAR_AFTER(pb + 8);
            if (IN(pb + 9) && (PHM & 1024)) for (int rep_ = 0; rep_ < ((REPM & 1024) ? 2 : 1); ++rep_) { pg8::Gemm g{act, (const bf16_t*)(ws + WS_WMD + (size_t)i2 * 8 * DM * DFE), 0, DM, DFE / 2, nullptr}; pg8::GroupedOrder S; S.initg(tab, DM, G, obid(), WGM_MDOWN);
                pg8::EpiFp8S E{(unsigned char*)(ws + WS_MIX)  , DM, 1.0f / WSCALE8}; pg8::gemm_phase<pg8::EpiFp8S, pg8::GroupedOrder, false, true>(lds, g, S, E); }
            BAR_AFTER(pb + 9);
        } else {
            if (IN(pb + 8) && (PHM & 2048)) for (int rep_ = 0; rep_ < ((REPM & 2048) ? 2 : 1); ++rep_) { pg8::Gemm g{hb, (const bf16_t*)(ws + WS_WFGU + (size_t)i2 * 2 * DFF * DM), NT, 2 * DFF, DM / 2, nullptr}; pg8::StaticOrder S; S.init(NT, 2 * DFF, G, obid(), WGM_FUP);
                pg8::EpiSwiglu8 E{(unsigned char*)act, DFF, 1.0f / WSCALE8}; pg8::gemm_phase<pg8::EpiSwiglu8, pg8::StaticOrder, false, true>(lds, g, S, E); }
            BAR_AFTER(pb + 8);
            if (IN(pb + 9) && (PHM & 4096)) for (int rep_ = ((REPM & 4096) ? 1 : 0); rep_ >= 0; --rep_) { pg8::Gemm g{act, (const bf16_t*)(ws + WS_WFD + (size_t)i2 * DM * DFF), NT, DM, DFF / 2, nullptr}; pg8::StaticOrder S; S.init(NT, DM, G, obid(), WGM_FDOWN);
                pg8::EpiResB E{(const void*)xb, 0, rep_ ? (bf16_t*)(ws + WS_PROJ) : xb, 1.0f / WSCALE8}; pg8::gemm_phase<pg8::EpiResB, pg8::StaticOrder, false, true>(lds, g, S, E); }
            BAR_AFTER(pb + 9);
        }
    }
    { int lo2 = P.ph_lo, hi2 = P.ph_hi; asm volatile("" : "+s"(lo2), "+s"(hi2));
    if (lo2 <= NPH - 1 && NPH - 1 < hi2 && (PHM & 8192)) ph_norm<2>(lds, P, nullptr, xb, true, P.in[I_FNORM], nullptr, P.out); }
#undef IN
#undef BAR_AFTER
}

extern "C" void kernel_launch(void* const* d_in, const int* in_sizes, int n_in, void* d_out, int out_size, void* d_ws, size_t ws_size, hipStream_t stream) {
    static int grid = 0;
    if (grid == 0) {
        if (n_in != 20 || out_size != NT * DM || ws_size < WS_END) { fprintf(stderr, "kernel_launch: unexpected shapes (n_in %d, out %d, ws %zu, need %zu)\n", n_in, out_size, ws_size, (size_t)WS_END); grid = -1; return; }
        int dev = 0, cus = 0, per_cu = 0;
        if (hipGetDevice(&dev) != hipSuccess || hipDeviceGetAttribute(&cus, hipDeviceAttributeMultiprocessorCount, dev) != hipSuccess) { grid = -1; return; }
        if (hipFuncSetAttribute((const void*)hymba_fwd, hipFuncAttributeMaxDynamicSharedMemorySize, LDS_BYTES) != hipSuccess) { fprintf(stderr, "kernel_launch: hipFuncSetAttribute failed\n"); grid = -1; return; }
        if (hipOccupancyMaxActiveBlocksPerMultiprocessor(&per_cu, (const void*)hymba_fwd, 512, LDS_BYTES) != hipSuccess || per_cu < 1) { fprintf(stderr, "kernel_launch: occupancy query says %d\n", per_cu); }
        (void)hipGetLastError();
        grid = cus;
    }
    if (grid < 0) return;
    (void)hipMemsetAsync((char*)d_ws + WS_CTL, 0, CTL_BYTES, stream);
    Params p{};
    for (int i = 0; i < 20; ++i) p.in[i] = (const float*)d_in[i];
    p.out = (float*)d_out; p.ws = (unsigned char*)d_ws;
#if MK_PER_PHASE
    for (int k = 0; k < NPH; ++k) { p.ph_lo = k; p.ph_hi = k + 1; hipLaunchKernelGGL(hymba_fwd, dim3(grid), dim3(512), LDS_BYTES, stream, p); }
#else
    p.ph_lo = 0; p.ph_hi = NPH;
    hipLaunchKernelGGL(hymba_fwd, dim3(grid), dim3(512), LDS_BYTES, stream, p);
#endif
}
```

```cpp
#include <hip/hip_runtime.h>
#include <stdint.h>
#include <cstdio>

#ifndef INPROJ_FP8
#define INPROJ_FP8 1
#endif
#ifndef REF0
#define REF0 0.f
#endif
#ifndef PHM
#define PHM 0xFFFF
#endif
#ifndef REPM
#define REPM 0
#endif
#ifndef WGM_INPROJ
#define WGM_INPROJ 4
#endif
#ifndef WGM_OUT
#define WGM_OUT 4
#endif
#ifndef WGM_FUP
#define WGM_FUP 8
#endif
#ifndef WGM_FDOWN
#define WGM_FDOWN 4
#endif
#ifndef WGM_MUP
#define WGM_MUP 8
#endif
#ifndef WGM_MDOWN
#define WGM_MDOWN 4
#endif
#ifndef MK_PER_PHASE
#define MK_PER_PHASE 0
#endif

#define LAS __attribute__((address_space(3)))
typedef unsigned short bf16_t;
typedef short bf16x8 __attribute__((ext_vector_type(8)));
typedef short s16x4 __attribute__((ext_vector_type(4)));
typedef float f32x2 __attribute__((ext_vector_type(2)));
typedef float f32x4 __attribute__((ext_vector_type(4)));
typedef float f32x16 __attribute__((ext_vector_type(16)));
typedef unsigned u32x2 __attribute__((ext_vector_type(2)));
typedef unsigned u32x4 __attribute__((ext_vector_type(4)));

__device__ __forceinline__ int otid() { int t = threadIdx.x; asm volatile("" : "+v"(t)); return t; }

__device__ __forceinline__ int obid() { int b = blockIdx.x; asm volatile("" : "+s"(b)); return b; }

constexpr int DM = 2048, NB = 4, SEQ = 4096, NT = NB * SEQ, DEPTH = 4;
constexpr int NPROJ = 4864;
constexpr int DFF = 5632, DFE = 3584, NEXP = 8;
constexpr int MOE_MAXT = 136;
constexpr int PC_Q = 0, PC_KC = 1024, PC_VC = 1280, PC_KS = 1536, PC_VS = 1792, PC_KW = 2048, PC_VW = 2304, PC_POOL = 2560, PC_FQ = 3072, PC_FK = 3584, PC_FV = 4096;
constexpr float LOG2E = 1.4426950408889634f;
constexpr float QK_C2 = 0.08838834764831845f * 1.4426950408889634f;

constexpr size_t al256(size_t x) { return (x + 255) & ~(size_t)255; }
constexpr size_t WS_CTL = 0;
constexpr size_t CTL_BYTES = 65536;
constexpr size_t WS_X = CTL_BYTES;
constexpr size_t WS_H = WS_X + (size_t)NT * DM * 4;
constexpr size_t WS_PROJ = WS_H + (size_t)NT * DM * 2;
constexpr size_t WS_MIX = WS_PROJ + (size_t)NT * NPROJ * 2;
constexpr size_t WS_ACT = WS_MIX + (size_t)MOE_MAXT * 256 * DM * 2;
constexpr size_t WS_GF = WS_ACT + (size_t)MOE_MAXT * 256 * DFE * 2;
constexpr size_t WS_CUM = WS_GF + (size_t)NT * 32 * 4;
constexpr size_t WS_KC = WS_CUM + (size_t)16 * SEQ * 4;
constexpr size_t WS_ROUTE = WS_KC + (size_t)2 * 8 * 256 * 128 * 2;
constexpr size_t WS_HIST = WS_ROUTE + (size_t)NT * 8 * 4;
constexpr size_t WS_TAB = WS_HIST + 256 * 8 * 4;
constexpr size_t WS_B1 = WS_TAB + 256;
constexpr size_t WS_ILIST = WS_B1 + 8 * 128 * 4;
constexpr size_t WS_ROWTOK = WS_ILIST + 4096;
constexpr size_t WS_KSG = WS_ROWTOK + (size_t)MOE_MAXT * 256 * 4;
constexpr size_t WS_WIN = WS_KSG + 4096;
constexpr size_t WS_WOUT = WS_WIN + (size_t)DEPTH * NPROJ * DM * 2;
constexpr size_t WS_WFGU = WS_WOUT + (size_t)DEPTH * DM * DM * 2;
constexpr size_t WS_WFD = WS_WFGU + (size_t)2 * 2 * DFF * DM * 2;
constexpr size_t WS_WMGU = WS_WFD + (size_t)2 * DM * DFF * 2;
constexpr size_t WS_WMD = WS_WMGU + (size_t)16 * 2 * DFE * DM * 2;
constexpr size_t WS_WC1 = WS_WMD + (size_t)16 * DM * DFE * 2;
constexpr size_t WS_WC2 = WS_WC1 + (size_t)8 * 128 * 4096 * 2;
constexpr size_t WS_WPOOL = WS_WC2 + (size_t)8 * 128 * 128 * 2;
constexpr size_t WS_END = WS_WPOOL + (size_t)16 * 128 * 128 * 2;
static_assert((size_t)NT * DM * 4 <= (size_t)MOE_MAXT * 256 * DM * 2, "mixraw fits");
static_assert((size_t)NT * DFF * 2 <= (size_t)MOE_MAXT * 256 * DFE * 2, "act fits");
static_assert((size_t)MOE_MAXT * 256 * DM * 2 <= (size_t)NT * NPROJ * 2, "Hg fits");

#define XB_TMO      128
#define XB_XCNT(j)  (256  + 64 * (j))
#define XB_XSUB(j)  (1280 + 64 * (j))
#define XB_XGEN(j)  (2304 + 64 * (j))
#define XB_TOP      3328
#define XB_TOPGEN   3392
#define XCD_BAR_WORDS 3456
#define XB_SPIN_CAP (1u << 18)

__device__ __forceinline__ unsigned xb_ld(unsigned* p)              { return __hip_atomic_load(p, __ATOMIC_RELAXED, __HIP_MEMORY_SCOPE_AGENT); }
__device__ __forceinline__ unsigned xb_add(unsigned* p, unsigned v) { return __hip_atomic_fetch_add(p, v, __ATOMIC_RELAXED, __HIP_MEMORY_SCOPE_AGENT); }
__device__ __forceinline__ unsigned xb_xcc_id() { return (unsigned)__builtin_amdgcn_s_getreg((3 << 11) | 20) & 0xFu; }
#define XB_SPIN(cond, bar) do { unsigned _sp = 0; while (cond) { __builtin_amdgcn_s_sleep(1); \
    if ((++_sp & 255u) == 0u) { if (xb_ld(&(bar)[XB_TMO])) break; if (_sp > XB_SPIN_CAP) { atomicAdd(&(bar)[XB_TMO], 1u); break; } } } } while (0)

struct XcdBarrier { unsigned* bar; unsigned x; volatile LAS unsigned* st; };

__device__ __forceinline__ XcdBarrier xcd_barrier_post(unsigned* bar, volatile LAS unsigned* st) {
    XcdBarrier b; b.bar = bar; b.x = xb_xcc_id(); b.st = st;
    if (threadIdx.x == 0) (void)xb_add(&bar[XB_XCNT(b.x)], 1u);
    return b;
}
__device__ __forceinline__ void xcd_barrier_complete(unsigned* bar, unsigned x, unsigned& nloc, unsigned& nx) {
    const unsigned G = gridDim.x * gridDim.y * gridDim.z;
    unsigned sum, cnt, mine, sp = 0u;
    for (;;) {
        sum = 0u; cnt = 0u; mine = 0u;
#pragma unroll
        for (unsigned j = 0; j < 16; ++j) { const unsigned c = xb_ld(&bar[XB_XCNT(j)]); sum += c; cnt += (c > 0u) ? 1u : 0u; mine = (j == x) ? c : mine; }
        if (sum == G) break;
        __builtin_amdgcn_s_sleep(1);
        if ((++sp & 255u) == 0u) { if (xb_ld(&bar[XB_TMO])) break; if (sp > XB_SPIN_CAP) { atomicAdd(&bar[XB_TMO], 1u); break; } }
    }
    nloc = mine > 0u ? mine : 1u; nx = cnt > 0u ? cnt : 1u;
}
__device__ __forceinline__ void xcd_barrier(const XcdBarrier& b) {
    asm volatile("s_waitcnt vmcnt(0)" ::: "memory");
    __syncthreads();
    if (threadIdx.x == 0) {
        unsigned* bar = b.bar;
        __builtin_amdgcn_s_waitcnt(0);
        unsigned nloc = b.st[0], nx = b.st[1];
        if (nloc == 0u) { xcd_barrier_complete(bar, b.x, nloc, nx); b.st[0] = nloc; b.st[1] = nx; }
        const unsigned old = xb_add(&bar[XB_XSUB(b.x)], 1u);
        const unsigned gen = old / nloc;
        if (old + 1u == (gen + 1u) * nloc) {
            __builtin_amdgcn_fence(__ATOMIC_RELEASE, "agent");
            asm volatile("s_waitcnt vmcnt(0)" ::: "memory");
            const unsigned og = xb_add(&bar[XB_TOP], 1u);
            const unsigned tg = og / nx;
            if (og + 1u == (tg + 1u) * nx) xb_add(&bar[XB_TOPGEN], 1u);
            else XB_SPIN(xb_ld(&bar[XB_TOPGEN]) == tg, bar);
            __builtin_amdgcn_fence(__ATOMIC_ACQUIRE, "agent");
            xb_add(&bar[XB_XGEN(b.x)], 1u);
            asm volatile("s_waitcnt vmcnt(0)" ::: "memory");
        } else {
            XB_SPIN(xb_ld(&bar[XB_XGEN(b.x)]) == gen, bar);
            __builtin_amdgcn_fence(__ATOMIC_ACQUIRE, "agent");
            asm volatile("s_waitcnt vmcnt(0)" ::: "memory");
        }
    }
    __syncthreads();
}

namespace pg8 {
constexpr int BM = 256, BK = 64, HALF = 128, HTB = HALF * BK * 2, STAGE_BYTES = 8 * HTB, NXCD = 8;
__host__ __device__ __forceinline__ int lds_byte(int r, int c) { const int st = (r >> 4) * 2 + (c >> 5), rr = r & 15, cc = c & 31, ob = rr * 64 + cc * 2; return st * 1024 + (ob ^ (((ob >> 9) & 1) << 5)); }
__host__ __device__ __forceinline__ void stage_rc(int b, int& R, int& C) { const int st = b / 1024, sb = b % 1024, swz = sb ^ (((sb >> 9) & 1) << 5); R = (st >> 1) * 16 + swz / 64; C = (st & 1) * 32 + (swz % 64) / 2; }
__host__ __device__ __forceinline__ int perm32(int rho) { const int n = rho >> 4, i = rho & 15; return 8 * (i >> 2) + 4 * n + (i & 3); }

struct Unit { int pm, pn; };
struct Gemm { const bf16_t* A; const bf16_t* Bt; int M, N, K; const int* rowmap; };

struct StaticOrder {
    int nM, nN, nwg, G, c, WGM;
    __device__ void init(int M, int N, int G_, int c_, int wgm = 4) { nM = M / BM; nN = N / BM; nwg = nM * nN; G = G_; c = c_; WGM = wgm; }
    __device__ bool next(int i, Unit& u) const {
        const long L = (long)i * G + c; if (L >= nwg) return false;
        int wgid = (int)L; { const int q = nwg / NXCD, r = nwg % NXCD, xcd = wgid % NXCD, off = wgid / NXCD; wgid = (xcd < r ? xcd * (q + 1) : r * (q + 1) + (xcd - r) * q) + off; }
        const int nig = WGM * nN, gid = wgid / nig, fm = gid * WGM, gsz = (nM - fm) < WGM ? (nM - fm) : WGM;
        u.pm = fm + ((wgid % nig) % gsz); u.pn = (wgid % nig) / gsz; return true;
    }
    __device__ __forceinline__ int btile(const Unit& u) const { return u.pn; }
};
struct GroupedOrder : StaticOrder {
    int t1, t2, t3, t4, t5, t6, t7;
    __device__ void initg(const int* toff, int N, int G_, int c_, int wgm = 4) { t1 = toff[1]; t2 = toff[2]; t3 = toff[3]; t4 = toff[4]; t5 = toff[5]; t6 = toff[6]; t7 = toff[7]; init(toff[8] * BM, N, G_, c_, wgm); }
    __device__ __forceinline__ int btile(const Unit& u) const {
        const int p = u.pm; const int e = (p >= t1) + (p >= t2) + (p >= t3) + (p >= t4) + (p >= t5) + (p >= t6) + (p >= t7);
        return e * nN + u.pn; }
};

__device__ __forceinline__ unsigned cvt_pk_bf16(float lo, float hi) { unsigned r; asm volatile("v_cvt_pk_bf16_f32 %0, %1, %2" : "=v"(r) : "v"(lo), "v"(hi)); return r; }


template <class Epi, class Sched, bool GATHER = false, bool FP8 = false>
__device__ __forceinline__ void gemm_phase(LAS unsigned char* lds, const Gemm g, const Sched& S, const Epi& E) {
    const int tid = otid(), wid = __builtin_amdgcn_readfirstlane(tid >> 6), lane = tid & 63, wr = wid >> 2, wc = wid & 3, fr = lane & 15, fq = lane >> 4;
    const int K = g.K, nt = K / BK;
    unsigned voffA[2], voffB[2];
#pragma unroll
    for (int i = 0; i < 2; ++i) { int R, C; stage_rc(tid * 16 + i * 8192, R, C); const int Rb = Epi::PERM ? ((R & ~31) + perm32(R & 31)) : R;
        voffA[i] = (unsigned)(R * K + C) * 2u; voffB[i] = (unsigned)(Rb * K + C) * 2u; }
    const size_t kstep = (size_t)(BK * 2);
    const size_t hstep = (size_t)HALF * K * 2;
    const size_t tstep = 2 * hstep;
    const unsigned ldsw = (unsigned)wid * 1024u;
    const int aoff = lds_byte(wr * 64 + fr, fq * 8), boff = lds_byte(wc * 32 + fr, fq * 8);
#define PG8_SA(b, h) (((b) * 2 + (h)) * HTB)
#define PG8_SB(b, h) ((4 + (b) * 2 + (h)) * HTB)
#define PG8_STAGE(bufoff, gbase, voff) do { _Pragma("unroll") for (int _i = 0; _i < 2; ++_i) \
        __builtin_amdgcn_global_load_lds((const unsigned*)((const char*)(gbase) + (voff)[_i]), (LAS unsigned*)(lds + (bufoff) + ldsw + _i * 8192), 16, 0, 0); } while (0)
#define PG8_STAGE_A(bufoff, kb, h, nx) do { if constexpr (GATHER) { const char* gb_ = (const char*)g.A + (kb); \
        _Pragma("unroll") for (int _i = 0; _i < 2; ++_i) { const unsigned o_ = (nx) ? gN[h][_i] : gA[h][_i]; \
            __builtin_amdgcn_global_load_lds((const unsigned*)(gb_ + o_), (LAS unsigned*)(lds + (bufoff) + ldsw + _i * 8192), 16, 0, 0); } } \
    else { PG8_STAGE(bufoff, ((nx) ? nA : cA) + (kb) + (h) * hstep, voffA); } } while (0)
#define PG8_LDA(dst, b, h) do { if constexpr (FP8) { _Pragma("unroll") for (int m = 0; m < 4; ++m) { const v4i_ lo_ = *(const LAS v4i_*)(lds + PG8_SA(b, h) + aoff + m * 2048), hi_ = *(const LAS v4i_*)(lds + PG8_SA(b, h) + aoff + m * 2048 + 1024); \
            dst##8[m] = __builtin_shufflevector(lo_, hi_, 0, 1, 2, 3, 4, 5, 6, 7); } } \
        else { _Pragma("unroll") for (int m = 0; m < 4; ++m) _Pragma("unroll") for (int k = 0; k < 2; ++k) dst[m][k] = *(const LAS bf16x8*)(lds + PG8_SA(b, h) + aoff + m * 2048 + k * 1024); } } while (0)
#define PG8_LDB(dst, b, h) do { if constexpr (FP8) { _Pragma("unroll") for (int n = 0; n < 2; ++n) { const v4i_ lo_ = *(const LAS v4i_*)(lds + PG8_SB(b, h) + boff + n * 2048), hi_ = *(const LAS v4i_*)(lds + PG8_SB(b, h) + boff + n * 2048 + 1024); \
            dst##8[n] = __builtin_shufflevector(lo_, hi_, 0, 1, 2, 3, 4, 5, 6, 7); } } \
        else { _Pragma("unroll") for (int n = 0; n < 2; ++n) _Pragma("unroll") for (int k = 0; k < 2; ++k) dst[n][k] = *(const LAS bf16x8*)(lds + PG8_SB(b, h) + boff + n * 2048 + k * 1024); } } while (0)
#define PG8_MMA(ai, bj, At, Bt) do { __builtin_amdgcn_s_setprio(1); _Pragma("unroll") for (int m = 0; m < 4; ++m) _Pragma("unroll") for (int n = 0; n < 2; ++n) { \
        if constexpr (FP8) asm volatile("v_mfma_scale_f32_16x16x128_f8f6f4 %0, %1, %2, %0, %3, %3 op_sel_hi:[0,0,0]" : "+v"(acc[ai][bj][m][n]) : "v"(Bt##8[n]), "v"(At##8[m]), "v"(sc8_));   \
        else { _Pragma("unroll") for (int k = 0; k < 2; ++k) acc[ai][bj][m][n] = __builtin_amdgcn_mfma_f32_16x16x32_bf16(Bt[n][k], At[m][k], acc[ai][bj][m][n], 0, 0, 0); } } \
        __builtin_amdgcn_s_setprio(0); } while (0)
#define PG8_WAIT_V(n) asm volatile("s_waitcnt vmcnt(" #n ")" ::: "memory")
#define PG8_WAIT_L(n) asm volatile("s_waitcnt lgkmcnt(" #n ")" ::: "memory")
#define PG8_BAR __builtin_amdgcn_s_barrier()
#define PG8_SCHED __builtin_amdgcn_sched_barrier(0)
    Unit cur, nxt; int ui = 0;
    if (!S.next(0, cur)) return;
    f32x4 acc[2][2][4][2];
#pragma unroll
    for (int a = 0; a < 2; ++a)
#pragma unroll
        for (int b = 0; b < 2; ++b)
#pragma unroll
            for (int m = 0; m < 4; ++m)
#pragma unroll
                for (int n = 0; n < 2; ++n) acc[a][b][m][n] = (f32x4){0.f, 0.f, 0.f, 0.f};
    typedef int v8i_ __attribute__((ext_vector_type(8))); typedef int v4i_ __attribute__((ext_vector_type(4)));
    bf16x8 At[4][2], B0[2][2], B1[2][2];
    v8i_ At8[4], B08[2], B18[2];
    const int sc8_ = 0x7F7F7F7F;
    const char* cA = (const char*)g.A + (GATHER ? (size_t)0 : (size_t)cur.pm * tstep); const char* cB = (const char*)g.Bt + (size_t)S.btile(cur) * tstep;
    const char* nA = cA;
    unsigned gA[2][2], gN[2][2];
    if constexpr (GATHER) {
#pragma unroll
        for (int h = 0; h < 2; ++h)
#pragma unroll
            for (int i = 0; i < 2; ++i) { int R, C; stage_rc(tid * 16 + i * 8192, R, C); const int tok = g.rowmap[cur.pm * BM + h * HALF + R]; gA[h][i] = (unsigned)(tok * K + C) * 2u; gN[h][i] = gA[h][i]; }
    }
    PG8_STAGE(PG8_SB(0, 0), cB, voffB); PG8_STAGE_A(PG8_SA(0, 0), (size_t)0, 0, false); PG8_STAGE(PG8_SB(0, 1), cB + hstep, voffB); PG8_STAGE_A(PG8_SA(0, 1), (size_t)0, 1, false);
    if (wr == 1) PG8_BAR;
    PG8_WAIT_V(4); PG8_BAR;
    PG8_STAGE(PG8_SB(1, 0), cB + kstep, voffB); PG8_STAGE_A(PG8_SA(1, 0), kstep, 0, false); PG8_STAGE(PG8_SB(1, 1), cB + hstep + kstep, voffB);
    PG8_WAIT_V(6); PG8_BAR;
    for (;;) {
        const bool has_next = S.next(ui + 1, nxt);
        nA = (has_next && !GATHER) ? (const char*)g.A + (size_t)nxt.pm * tstep : cA; const char* nB = has_next ? (const char*)g.Bt + (size_t)S.btile(nxt) * tstep : cB;
        if constexpr (GATHER) { if (has_next && nxt.pm != cur.pm) {
#pragma unroll
            for (int h = 0; h < 2; ++h)
#pragma unroll
                for (int i = 0; i < 2; ++i) { int R, C; stage_rc(tid * 16 + i * 8192, R, C); const int tok = g.rowmap[nxt.pm * BM + h * HALF + R]; gN[h][i] = (unsigned)(tok * K + C) * 2u; } } }
        for (int t = 0; t < nt; t += 2) {
            const bool last = (t == nt - 2);
            const size_t k1 = (size_t)(t + 1) * kstep, k2 = last ? (size_t)0 : (size_t)(t + 2) * kstep, k3 = k2 + kstep;
            const char* b2 = last ? nB : cB + (size_t)(t + 2) * kstep;
            const char* b3 = b2 + kstep;
            PG8_LDB(B0, 0, 0); PG8_SCHED; PG8_LDA(At, 0, 0); PG8_STAGE_A(PG8_SA(1, 1), k1, 1, false);
            PG8_WAIT_L(8); PG8_BAR; PG8_WAIT_L(0); PG8_MMA(0, 0, At, B0); PG8_BAR; PG8_SCHED;
            PG8_LDB(B1, 0, 1); PG8_STAGE(PG8_SB(0, 0), b2, voffB);
            PG8_BAR; PG8_WAIT_L(0); PG8_MMA(0, 1, At, B1); PG8_BAR;
            PG8_LDA(At, 0, 1); PG8_STAGE_A(PG8_SA(0, 0), k2, 0, last);
            PG8_BAR; PG8_WAIT_L(0); PG8_MMA(1, 0, At, B0); PG8_BAR; PG8_SCHED;
            PG8_STAGE(PG8_SB(0, 1), b2 + hstep, voffB);
            PG8_WAIT_V(6); PG8_BAR; PG8_MMA(1, 1, At, B1); PG8_BAR;
            PG8_LDB(B0, 1, 0); PG8_SCHED; PG8_LDA(At, 1, 0); PG8_STAGE_A(PG8_SA(0, 1), k2, 1, last);
            PG8_WAIT_L(8); PG8_BAR; PG8_WAIT_L(0); PG8_MMA(0, 0, At, B0); PG8_BAR; PG8_SCHED;
            PG8_LDB(B1, 1, 1); PG8_STAGE(PG8_SB(1, 0), b3, voffB);
            PG8_BAR; PG8_WAIT_L(0); PG8_MMA(0, 1, At, B1); PG8_BAR;
            PG8_LDA(At, 1, 1); PG8_STAGE_A(PG8_SA(1, 0), k3, 0, last);
            PG8_BAR; PG8_WAIT_L(0); PG8_MMA(1, 0, At, B0); PG8_BAR; PG8_SCHED;
            PG8_STAGE(PG8_SB(1, 1), b3 + hstep, voffB);
            PG8_WAIT_V(6); PG8_BAR; PG8_MMA(1, 1, At, B1); PG8_BAR;
        }
        E(acc, cur, wr, wc, fr, fq);
        if (!has_next) break;
#pragma unroll
        for (int a = 0; a < 2; ++a)
#pragma unroll
            for (int b = 0; b < 2; ++b)
#pragma unroll
                for (int m = 0; m < 4; ++m)
#pragma unroll
                    for (int n = 0; n < 2; ++n) acc[a][b][m][n] = (f32x4){0.f, 0.f, 0.f, 0.f};
        cur = nxt; cA = nA; cB = nB; ++ui;
        if constexpr (GATHER) {
#pragma unroll
            for (int h = 0; h < 2; ++h)
#pragma unroll
                for (int i = 0; i < 2; ++i) gA[h][i] = gN[h][i]; }
    }
    PG8_WAIT_V(0);
    if (wr == 0) PG8_BAR;
    PG8_BAR;
#undef PG8_SA
#undef PG8_SB
#undef PG8_STAGE
#undef PG8_STAGE_A
#undef PG8_LDA
#undef PG8_LDB
#undef PG8_MMA
#undef PG8_WAIT_V
#undef PG8_WAIT_L
#undef PG8_BAR
#undef PG8_SCHED
}

struct EpiProj {
    static constexpr bool PERM = true;
    bf16_t* O; float* GF; float sc;
    __device__ __forceinline__ void operator()(const f32x4 (&acc)[2][2][4][2], const Unit& u, int wr, int wc, int fr, int fq) const {
        const int row0 = u.pm * BM + wr * 64 + fr; const float sc = (u.pn < 4 || u.pn == 12 || u.pn == 13) ? this->sc * QK_C2 : this->sc;
        if (u.pn < 18) {
            const int col0 = u.pn * BM + wc * 32 + 8 * fq;
#pragma unroll
            for (int ai = 0; ai < 2; ++ai)
#pragma unroll
                for (int m = 0; m < 4; ++m) { bf16_t* rowp = O + (size_t)(row0 + ai * HALF + m * 16) * NPROJ + col0;
#pragma unroll
                    for (int bj = 0; bj < 2; ++bj) { const f32x4 v0 = acc[ai][bj][m][0] * sc, v1 = acc[ai][bj][m][1] * sc;
                        u32x4 w; w.x = cvt_pk_bf16(v0[0], v0[1]); w.y = cvt_pk_bf16(v0[2], v0[3]); w.z = cvt_pk_bf16(v1[0], v1[1]); w.w = cvt_pk_bf16(v1[2], v1[3]);
                        *(u32x4*)(rowp + bj * HALF) = w; } }
        } else if (wc == 0) {
#pragma unroll
            for (int ai = 0; ai < 2; ++ai)
#pragma unroll
                for (int m = 0; m < 4; ++m) { float* rowp = GF + (size_t)(row0 + ai * HALF + m * 16) * 32 + 8 * fq;
                    *(f32x4*)(rowp) = acc[ai][0][m][0] * sc; *(f32x4*)(rowp + 4) = acc[ai][0][m][1] * sc; }
        }
    }
};
struct EpiResF32 {
    static constexpr bool PERM = false;
    const float* res; float* out; float sc;
    __device__ __forceinline__ void operator()(const f32x4 (&acc)[2][2][4][2], const Unit& u, int wr, int wc, int fr, int fq) const {
        const int row0 = u.pm * BM + wr * 64 + fr, col0 = u.pn * BM + wc * 32 + 4 * fq;
        f32x4 rv[2][2][2][2];
#define ERF_LOAD(par, g_) do { const int ai_ = (g_) >> 1, mp_ = (g_) & 1; _Pragma("unroll") for (int mm = 0; mm < 2; ++mm) { const size_t off_ = (size_t)(row0 + ai_ * HALF + (mp_ * 2 + mm) * 16) * DM + col0; \
            _Pragma("unroll") for (int bj = 0; bj < 2; ++bj) _Pragma("unroll") for (int n = 0; n < 2; ++n) rv[par][mm][bj][n] = *(const f32x4*)(res + off_ + bj * HALF + n * 16); } } while (0)
#define ERF_STORE(par, g_) do { const int ai_ = (g_) >> 1, mp_ = (g_) & 1; _Pragma("unroll") for (int mm = 0; mm < 2; ++mm) { const size_t off_ = (size_t)(row0 + ai_ * HALF + (mp_ * 2 + mm) * 16) * DM + col0; \
            _Pragma("unroll") for (int bj = 0; bj < 2; ++bj) _Pragma("unroll") for (int n = 0; n < 2; ++n) *(f32x4*)(out + off_ + bj * HALF + n * 16) = rv[par][mm][bj][n] + acc[ai_][bj][mp_ * 2 + mm][n] * sc; } } while (0)
        ERF_LOAD(0, 0); asm volatile("" ::: "memory");
        ERF_LOAD(1, 1); asm volatile("" ::: "memory");
        ERF_STORE(0, 0); asm volatile("" ::: "memory");
        ERF_LOAD(0, 2); asm volatile("" ::: "memory");
        ERF_STORE(1, 1); asm volatile("" ::: "memory");
        ERF_LOAD(1, 3); asm volatile("" ::: "memory");
        ERF_STORE(0, 2); asm volatile("" ::: "memory");
        ERF_STORE(1, 3);
#undef ERF_LOAD
#undef ERF_STORE
    }
};
struct EpiResB {
    static constexpr bool PERM = true;
    const void* res; int res_f32; bf16_t* out; float sc;
    __device__ __forceinline__ void operator()(const f32x4 (&acc)[2][2][4][2], const Unit& u, int wr, int wc, int fr, int fq) const {
        const int row0 = u.pm * BM + wr * 64 + fr, col0 = u.pn * BM + wc * 32 + 8 * fq;
        if (res_f32) {
            const float* rf = (const float*)res;
#pragma unroll
            for (int ai = 0; ai < 2; ++ai)
#pragma unroll
                for (int mp = 0; mp < 2; ++mp) { f32x4 rv[2][2][2];
#pragma unroll
                    for (int mm = 0; mm < 2; ++mm) { const size_t off = (size_t)(row0 + ai * HALF + (mp * 2 + mm) * 16) * DM + col0;
#pragma unroll
                        for (int bj = 0; bj < 2; ++bj)
#pragma unroll
                            for (int n = 0; n < 2; ++n) rv[mm][bj][n] = *(const f32x4*)(rf + off + bj * HALF + n * 4); }
#pragma unroll
                    for (int mm = 0; mm < 2; ++mm) { const size_t off = (size_t)(row0 + ai * HALF + (mp * 2 + mm) * 16) * DM + col0;
#pragma unroll
                        for (int bj = 0; bj < 2; ++bj) { const f32x4 v0 = rv[mm][bj][0] + acc[ai][bj][mp * 2 + mm][0] * sc, v1 = rv[mm][bj][1] + acc[ai][bj][mp * 2 + mm][1] * sc;
                            u32x4 w; w.x = cvt_pk_bf16(v0[0], v0[1]); w.y = cvt_pk_bf16(v0[2], v0[3]); w.z = cvt_pk_bf16(v1[0], v1[1]); w.w = cvt_pk_bf16(v1[2], v1[3]);
                            *(u32x4*)(out + off + bj * HALF) = w; } }
                    asm volatile("" ::: "memory"); }
        } else {
            const bf16_t* rb = (const bf16_t*)res;
            u32x4 rv[2][4][2];
#define ERB_LOAD(par, ai_) do { _Pragma("unroll") for (int m = 0; m < 4; ++m) { const size_t off_ = (size_t)(row0 + (ai_) * HALF + m * 16) * DM + col0; \
            _Pragma("unroll") for (int bj = 0; bj < 2; ++bj) rv[par][m][bj] = *(const u32x4*)(rb + off_ + bj * HALF); } } while (0)
#define ERB_STORE(par, ai_) do { _Pragma("unroll") for (int m = 0; m < 4; ++m) { const size_t off_ = (size_t)(row0 + (ai_) * HALF + m * 16) * DM + col0; \
            _Pragma("unroll") for (int bj = 0; bj < 2; ++bj) { const u32x4 r_ = rv[par][m][bj]; const f32x4 a0_ = acc[ai_][bj][m][0] * sc, a1_ = acc[ai_][bj][m][1] * sc; u32x4 w; \
                w.x = cvt_pk_bf16(__uint_as_float(r_.x << 16) + a0_[0], __uint_as_float(r_.x & 0xffff0000u) + a0_[1]); w.y = cvt_pk_bf16(__uint_as_float(r_.y << 16) + a0_[2], __uint_as_float(r_.y & 0xffff0000u) + a0_[3]); \
                w.z = cvt_pk_bf16(__uint_as_float(r_.z << 16) + a1_[0], __uint_as_float(r_.z & 0xffff0000u) + a1_[1]); w.w = cvt_pk_bf16(__uint_as_float(r_.w << 16) + a1_[2], __uint_as_float(r_.w & 0xffff0000u) + a1_[3]); \
                *(u32x4*)(out + off_ + bj * HALF) = w; } } } while (0)
            ERB_LOAD(0, 0); asm volatile("" ::: "memory");
            ERB_LOAD(1, 1); asm volatile("" ::: "memory");
            ERB_STORE(0, 0); asm volatile("" ::: "memory");
            ERB_STORE(1, 1);
#undef ERB_LOAD
#undef ERB_STORE
        }
    }
};
struct EpiSwiglu {
    static constexpr bool PERM = true;
    bf16_t* O; int ldc;
    __device__ __forceinline__ void operator()(const f32x4 (&acc)[2][2][4][2], const Unit& u, int wr, int wc, int fr, int fq) const {
        const int row0 = u.pm * BM + wr * 64 + fr, col0 = u.pn * HALF + wc * 32 + 8 * fq;
#pragma unroll
        for (int ai = 0; ai < 2; ++ai)
#pragma unroll
            for (int m = 0; m < 4; ++m) { bf16_t* rowp = O + (size_t)(row0 + ai * HALF + m * 16) * ldc + col0;
                float a[8];
#pragma unroll
                for (int n = 0; n < 2; ++n)
#pragma unroll
                    for (int i = 0; i < 4; ++i) { const float gv = acc[ai][0][m][n][i], uv = acc[ai][1][m][n][i];
                        const float sg = gv * __builtin_amdgcn_rcpf(1.0f + __builtin_amdgcn_exp2f(-gv * LOG2E)); a[n * 4 + i] = sg * uv; }
                u32x4 w; w.x = cvt_pk_bf16(a[0], a[1]); w.y = cvt_pk_bf16(a[2], a[3]); w.z = cvt_pk_bf16(a[4], a[5]); w.w = cvt_pk_bf16(a[6], a[7]);
                *(u32x4*)rowp = w; }
    }
};
struct EpiBf16 {
    static constexpr bool PERM = true;
    bf16_t* O; int ldc;
    __device__ __forceinline__ void operator()(const f32x4 (&acc)[2][2][4][2], const Unit& u, int wr, int wc, int fr, int fq) const {
        const int row0 = u.pm * BM + wr * 64 + fr, col0 = u.pn * BM + wc * 32 + 8 * fq;
#pragma unroll
        for (int ai = 0; ai < 2; ++ai)
#pragma unroll
            for (int m = 0; m < 4; ++m) { bf16_t* rowp = O + (size_t)(row0 + ai * HALF + m * 16) * ldc + col0;
#pragma unroll
                for (int bj = 0; bj < 2; ++bj) { const f32x4 v0 = acc[ai][bj][m][0], v1 = acc[ai][bj][m][1];
                    u32x4 w; w.x = cvt_pk_bf16(v0[0], v0[1]); w.y = cvt_pk_bf16(v0[2], v0[3]); w.z = cvt_pk_bf16(v1[0], v1[1]); w.w = cvt_pk_bf16(v1[2], v1[3]);
                    *(u32x4*)(rowp + bj * HALF) = w; } }
    }
};
__device__ __forceinline__ unsigned pack_fp8x4(float a, float b, float c, float d) { unsigned w = 0; w = __builtin_amdgcn_cvt_pk_fp8_f32(a, b, w, false); w = __builtin_amdgcn_cvt_pk_fp8_f32(c, d, w, true); return w; }
struct EpiSwiglu8 {
    static constexpr bool PERM = true;
    unsigned char* O; int ldc; float sc;
    __device__ __forceinline__ void operator()(const f32x4 (&acc)[2][2][4][2], const Unit& u, int wr, int wc, int fr, int fq) const {
        const int row0 = u.pm * BM + wr * 64 + fr, col0 = u.pn * HALF + wc * 32 + 8 * fq;
#pragma unroll
        for (int ai = 0; ai < 2; ++ai)
#pragma unroll
            for (int m = 0; m < 4; ++m) { unsigned char* rowp = O + (size_t)(row0 + ai * HALF + m * 16) * ldc + col0;
                float a[8];
#pragma unroll
                for (int n = 0; n < 2; ++n)
#pragma unroll
                    for (int i = 0; i < 4; ++i) { const float gv = acc[ai][0][m][n][i] * sc, uv = acc[ai][1][m][n][i] * sc;
                        const float sg = gv * __builtin_amdgcn_rcpf(1.0f + __builtin_amdgcn_exp2f(-gv * LOG2E)); a[n * 4 + i] = sg * uv; }
                u32x2 w; w.x = pack_fp8x4(a[0], a[1], a[2], a[3]); w.y = pack_fp8x4(a[4], a[5], a[6], a[7]);
                *(u32x2*)rowp = w; }
    }
};
struct EpiFp8S {
    static constexpr bool PERM = true;
    unsigned char* O; int ldc; float sc;
    __device__ __forceinline__ void operator()(const f32x4 (&acc)[2][2][4][2], const Unit& u, int wr, int wc, int fr, int fq) const {
        const int row0 = u.pm * BM + wr * 64 + fr, col0 = u.pn * BM + wc * 32 + 8 * fq;
#pragma unroll
        for (int ai = 0; ai < 2; ++ai)
#pragma unroll
            for (int m = 0; m < 4; ++m) { unsigned char* rowp = O + (size_t)(row0 + ai * HALF + m * 16) * ldc + col0;
#pragma unroll
                for (int bj = 0; bj < 2; ++bj) { const f32x4 v0 = acc[ai][bj][m][0] * sc, v1 = acc[ai][bj][m][1] * sc;
                    u32x2 w; w.x = pack_fp8x4(v0[0], v0[1], v0[2], v0[3]); w.y = pack_fp8x4(v1[0], v1[1], v1[2], v1[3]);
                    *(u32x2*)(rowp + bj * HALF) = w; } }
    }
};
struct EpiBf16S {
    static constexpr bool PERM = true;
    bf16_t* O; int ldc; float sc;
    __device__ __forceinline__ void operator()(const f32x4 (&acc)[2][2][4][2], const Unit& u, int wr, int wc, int fr, int fq) const {
        const int row0 = u.pm * BM + wr * 64 + fr, col0 = u.pn * BM + wc * 32 + 8 * fq;
#pragma unroll
        for (int ai = 0; ai < 2; ++ai)
#pragma unroll
            for (int m = 0; m < 4; ++m) { bf16_t* rowp = O + (size_t)(row0 + ai * HALF + m * 16) * ldc + col0;
#pragma unroll
                for (int bj = 0; bj < 2; ++bj) { const f32x4 v0 = acc[ai][bj][m][0] * sc, v1 = acc[ai][bj][m][1] * sc;
                    u32x4 w; w.x = cvt_pk_bf16(v0[0], v0[1]); w.y = cvt_pk_bf16(v0[2], v0[3]); w.z = cvt_pk_bf16(v1[0], v1[1]); w.w = cvt_pk_bf16(v1[2], v1[3]);
                    *(u32x4*)(rowp + bj * HALF) = w; } }
    }
};
}

namespace at {
constexpr int SHM = 16384;
constexpr int OFF_V = 0, OFF_K = SHM  , OFF_WS = 4 * SHM, OFF_CK = 4 * SHM + 2048, OFF_IMP = 4 * SHM + 4096, OFF_MASK = OFF_IMP + 64 * 65 * 4, OFF_Q = OFF_MASK + 512, OFF_FOXB = OFF_Q + 64  , OFF_DEAD = OFF_FOXB + 512  , OFF_END = OFF_DEAD + 64;
static_assert(OFF_END <= 131072, "attention LDS map");
enum { M_WIN = 0, M_FOX = 1, M_SLC = 2, M_CMP = 3 };

#define KSWZ(row, colB) ((row) * 256 + ((colB) ^ (((row) & 7) << 4)))
#define SBAR() __builtin_amdgcn_sched_barrier(0)
#define BAR_LDS() do { asm volatile("s_waitcnt lgkmcnt(0)" ::: "memory"); __builtin_amdgcn_s_barrier(); asm volatile("" ::: "memory"); } while (0)
__device__ __forceinline__ int v_st(int k, int c) { const int kk = (k & ~0xC) | ((k & 4) << 1) | ((k & 8) >> 1); return ((kk >> 3) * 4 + (c >> 5)) * 512 + ((kk & 7) * 32 + (c & 31)) * 2; }
__device__ __forceinline__ int v_rd_base(int lane) { return ((lane & 3) << 3) | (((lane >> 2) & 3) << 6) | (((lane >> 4) & 1) << 5) | (((lane >> 5) & 1) << 8); }
constexpr int v_rd_off(int d0, int ks, int half) { return d0 * 512 + ks * 4096 + half * 2048; }
__device__ __forceinline__ int crow(int r, int hi) { return (r & 3) + 8 * (r >> 2) + 4 * hi; }
__device__ __forceinline__ unsigned cvtpk(float lo, float hi) { unsigned r; asm volatile("v_cvt_pk_bf16_f32 %0, %1, %2" : "=v"(r) : "v"(lo), "v"(hi)); return r; }

#ifndef QK_PF
#define QK_PF 2
#endif
__device__ __forceinline__ void qkt(f32x16& p0, f32x16& p1, LAS const char* K_lds, int r32, int hi, const bf16x8 (&qr)[8]) {
#pragma unroll
    for (int r = 0; r < 16; ++r) { p0[r] = 0.f; p1[r] = 0.f; }
    LAS const char* kb[4];
#pragma unroll
    for (int dd = 0; dd < 4; ++dd) kb[dd] = K_lds + KSWZ(r32, (dd * 16 + hi * 8) * 2);
    bf16x8 f0[QK_PF], f1[QK_PF];
#pragma unroll
    for (int d0 = 0; d0 < QK_PF; ++d0) { LAS const char* a = kb[d0 & 3] + (d0 >> 2) * 128; f0[d0] = *(LAS const bf16x8*)a; f1[d0] = *(LAS const bf16x8*)(a + 32 * 256); }
    SBAR();
#pragma unroll
    for (int d0 = 0; d0 < 8; ++d0) {
        p0 = __builtin_amdgcn_mfma_f32_32x32x16_bf16(f0[d0 % QK_PF], qr[d0], p0, 0, 0, 0);
        p1 = __builtin_amdgcn_mfma_f32_32x32x16_bf16(f1[d0 % QK_PF], qr[d0], p1, 0, 0, 0);
        if (d0 + QK_PF < 8) { LAS const char* a = kb[(d0 + QK_PF) & 3] + ((d0 + QK_PF) >> 2) * 128; f0[d0 % QK_PF] = *(LAS const bf16x8*)a; f1[d0 % QK_PF] = *(LAS const bf16x8*)(a + 32 * 256); }
        SBAR(); }
}
__device__ __forceinline__ void pv_tile(f32x16 (&o)[4], unsigned vb0, bf16x8 pa0, bf16x8 pa1, bf16x8 pa2, bf16x8 pa3) {
#define TRRD(dst, off) asm volatile("ds_read_b64_tr_b16 %0, %1 offset:%2" : "=&v"(dst) : "v"(vb0), "i"(off) : "memory")
#define PV_D0(d0) do { s16x4 l0, l1, l2, l3, h0, h1, h2, h3; constexpr int b_ = v_rd_off(d0, 0, 0); \
        TRRD(l0, b_); TRRD(h0, b_ + 2048); TRRD(l1, b_ + 4096); TRRD(h1, b_ + 6144); TRRD(l2, b_ + 8192); TRRD(h2, b_ + 10240); TRRD(l3, b_ + 12288); TRRD(h3, b_ + 14336); \
        asm volatile("s_waitcnt lgkmcnt(0)" ::: "memory"); SBAR(); \
        o[d0] = __builtin_amdgcn_mfma_f32_32x32x16_bf16(pa0, (bf16x8){l0[0], l0[1], l0[2], l0[3], h0[0], h0[1], h0[2], h0[3]}, o[d0], 0, 0, 0); \
        o[d0] = __builtin_amdgcn_mfma_f32_32x32x16_bf16(pa1, (bf16x8){l1[0], l1[1], l1[2], l1[3], h1[0], h1[1], h1[2], h1[3]}, o[d0], 0, 0, 0); \
        o[d0] = __builtin_amdgcn_mfma_f32_32x32x16_bf16(pa2, (bf16x8){l2[0], l2[1], l2[2], l2[3], h2[0], h2[1], h2[2], h2[3]}, o[d0], 0, 0, 0); \
        o[d0] = __builtin_amdgcn_mfma_f32_32x32x16_bf16(pa3, (bf16x8){l3[0], l3[1], l3[2], l3[3], h3[0], h3[1], h3[2], h3[3]}, o[d0], 0, 0, 0); } while (0)
    PV_D0(0); PV_D0(1); PV_D0(2); PV_D0(3);
#undef PV_D0
#undef TRRD
}
__device__ __forceinline__ void mask_range(f32x16& p0, f32x16& p1, int hi, int lo, int len) {
    const float NEG = -__builtin_inff(); const int b = 4 * hi - lo; const unsigned ul = (unsigned)(len < 0 ? 0 : len);
#pragma unroll
    for (int r = 0; r < 16; ++r) { const int c = (r & 3) + 8 * (r >> 2);
        if ((unsigned)(c + b) >= ul) p0[r] = NEG;
        if ((unsigned)(c + 32 + b) >= ul) p1[r] = NEG; }
}
__device__ __forceinline__ void pack_p(const f32x16& p0, const f32x16& p1, bf16x8& pa0, bf16x8& pa1, bf16x8& pa2, bf16x8& pa3) {
#define PK4(P, B_, OUT) do { unsigned a0 = cvtpk(P[B_+0], P[B_+1]), a1 = cvtpk(P[B_+2], P[B_+3]); \
        unsigned b0 = cvtpk(P[B_+4], P[B_+5]), b1 = cvtpk(P[B_+6], P[B_+7]); \
        auto r0 = __builtin_amdgcn_permlane32_swap(a0, b0, false, false); auto r1 = __builtin_amdgcn_permlane32_swap(a1, b1, false, false); \
        u32x4 w = {r0[0], r1[0], r0[1], r1[1]}; OUT = *reinterpret_cast<bf16x8*>(&w); } while (0)
    PK4(p0, 0, pa0); PK4(p0, 8, pa1); PK4(p1, 0, pa2); PK4(p1, 8, pa3);
#undef PK4
}

struct LaneCtx {
    int qpos;
    int nvis;
    unsigned mlo, mhi;
    int cur;
    float cq2;
    float m_fin, inv_l;
    int wave_qmax;
    float qn;
};
constexpr float DEFER_THR = 11.5f;
constexpr float IMP_SCALE = 67108864.f;

template <int MODE, int PASS>
__device__ __forceinline__ void attn_loop(LAS char* lds, const bf16_t* Kg, const bf16_t* Vg, int ldkv, const float* ckg, int t_lo, int t_hi,
                                          const bf16x8 (&qr)[8], const LaneCtx& cx, f32x16 (&o)[4], float& m_reg, float& l_reg) {
    const int tid = otid(), wid = __builtin_amdgcn_readfirstlane(tid >> 6), lane = tid & 63, r32 = lane & 31, hi = lane >> 5;
    LAS float* al_l = (LAS float*)(lds + OFF_WS) + wid * 64;
    const int sr = tid >> 4, sc = (tid & 15) * 8;
    const int kws = KSWZ(sr, sc * 2), vst0 = v_st(sr, sc), vst1 = v_st(32 + sr, sc);
    bf16x8 sk0, sk1, sv0, sv1; float sck = 0.f;
    const unsigned soff = (unsigned)(sr * ldkv + sc);
    const int nt = t_hi - t_lo;
#define AT_LOAD(t) do { const bf16_t* kt_ = Kg + (size_t)(64 * (t)) * ldkv; const bf16_t* kt2_ = kt_ + (size_t)32 * ldkv; sk0 = *(const bf16x8*)(kt_ + soff); sk1 = *(const bf16x8*)(kt2_ + soff); \
        if (PASS != 1) { const bf16_t* vt_ = Vg + (size_t)(64 * (t)) * ldkv; const bf16_t* vt2_ = vt_ + (size_t)32 * ldkv; sv0 = *(const bf16x8*)(vt_ + soff); sv1 = *(const bf16x8*)(vt2_ + soff); } \
        if (MODE == M_FOX) { if (tid < 64) sck = ckg[64 * (t) + tid]; } } while (0)
#define AT_WRITE(bf) do { LAS char* b_ = lds + (bf) * 32768; *(LAS bf16x8*)(b_ + OFF_K + kws) = sk0; *(LAS bf16x8*)(b_ + OFF_K + kws + 32 * 256) = sk1; \
        if (PASS != 1) { *(LAS bf16x8*)(b_ + OFF_V + vst0) = sv0; *(LAS bf16x8*)(b_ + OFF_V + vst1) = sv1; } \
        if (MODE == M_FOX) { if (tid < 64) ((LAS float*)(lds + OFF_CK))[(bf) * 64 + tid] = sck; } } while (0)
#define AT_TILE(i_) ((MODE == M_FOX) ? (t_hi - 1 - (i_)) : (t_lo + (i_)))
    if (nt > 0) AT_LOAD(AT_TILE(0));
    BAR_LDS();
    if (nt > 0) AT_WRITE(0);
    if (nt > 1) AT_LOAD(AT_TILE(1));
    if (MODE == M_FOX) { if (lane == 0) { ((LAS unsigned*)(lds + OFF_DEAD))[wid] = 0u; ((LAS unsigned*)(lds + OFF_DEAD))[8 + wid] = 0u; } }
    BAR_LDS();
    if (wid >= 4) __builtin_amdgcn_s_setprio(1);
    bool dead = false;
    for (int i = 0; i < nt; ++i) {
        const int t = AT_TILE(i), bf = i & 1;
        if (MODE == M_FOX) {
            if (i > 0) { const u32x4 d0_ = *(LAS const u32x4*)(lds + OFF_DEAD + ((i - 1) & 1) * 32), d1_ = *(LAS const u32x4*)(lds + OFF_DEAD + ((i - 1) & 1) * 32 + 16);
                if ((d0_.x & d0_.y & d0_.z & d0_.w & d1_.x & d1_.y & d1_.z & d1_.w) != 0u) break; }
            if (!dead) { const float ks_ = ((LAS const float*)(lds + OFF_FOXB))[t], cm_ = ((LAS const float*)(lds + OFF_FOXB))[64 + t];
                dead = __all(cx.qn * ks_ + cx.cq2 - cm_ - m_reg < -160.0f); }
            if (lane == 0) ((LAS unsigned*)(lds + OFF_DEAD))[(i & 1) * 8 + wid] = dead ? 1u : 0u;
        }
        LAS char* K_lds = lds + bf * 32768 + OFF_K;
        const unsigned vb0 = (unsigned)(size_t)(lds + bf * 32768 + OFF_V) + (unsigned)v_rd_base(lane);
        LAS float* ck_l = (LAS float*)(lds + OFF_CK) + bf * 64;
        const int kb = 64 * t;
        bool act = true;
        if (MODE == M_FOX) act = (kb <= cx.wave_qmax) && !dead;
        if (act) {
            f32x16 p0, p1;
            qkt(p0, p1, K_lds, r32, hi, qr);
            if (MODE == M_FOX) {
#pragma unroll
                for (int a = 0; a < 4; ++a) { const f32x4 c0 = *(LAS const f32x4*)(ck_l + 8 * a + 4 * hi), c1 = *(LAS const f32x4*)(ck_l + 32 + 8 * a + 4 * hi);
#pragma unroll
                    for (int j = 0; j < 4; ++j) { p0[4 * a + j] = p0[4 * a + j] + (cx.cq2 - c0[j]); p1[4 * a + j] = p1[4 * a + j] + (cx.cq2 - c1[j]); } }
            }
            constexpr float SC = 1.0f;
            int lo, len;
            if (MODE == M_WIN) { lo = cx.qpos - 511 - kb; len = 512; }
            else if (MODE == M_FOX) { lo = -64; len = cx.qpos - kb + 65; }
            else if (MODE == M_SLC) { if (t < cx.cur) { lo = 0; len = 64; } else { lo = -64; len = cx.qpos - kb + 65; } }
            else { lo = -64; len = cx.nvis - kb + 64; }
            if (!__all(lo <= 0 && lo + len >= 64)) mask_range(p0, p1, hi, lo, len);
            bool sel = true;
            if (MODE == M_SLC) sel = ((t < 32 ? (cx.mlo >> t) : (cx.mhi >> (t - 32))) & 1u) != 0u;
            if (PASS == 2) {
                const float mf = -cx.m_fin;
#pragma unroll
                for (int r = 0; r < 16; ++r) { p0[r] = __builtin_amdgcn_exp2f(fmaf(p0[r], SC, mf)) * cx.inv_l; p1[r] = __builtin_amdgcn_exp2f(fmaf(p1[r], SC, mf)) * cx.inv_l; }
                LAS unsigned* ip = (LAS unsigned*)(lds + OFF_IMP) + ((wid & 1) * 32 + r32) * 65;
#pragma unroll
                for (int a = 0; a < 4; ++a) {
                    const int jA = 16 * t + 2 * a + hi, jB = jA + 8;
                    const float s0 = (p0[4 * a] + p0[4 * a + 1]) + (p0[4 * a + 2] + p0[4 * a + 3]);
                    const float s1 = (p1[4 * a] + p1[4 * a + 1]) + (p1[4 * a + 2] + p1[4 * a + 3]);
                    __hip_atomic_fetch_add(ip + jA, (unsigned)(s0 * IMP_SCALE + 0.5f), __ATOMIC_RELAXED, __HIP_MEMORY_SCOPE_WORKGROUP);
                    __hip_atomic_fetch_add(ip + jB, (unsigned)(s1 * IMP_SCALE + 0.5f), __ATOMIC_RELAXED, __HIP_MEMORY_SCOPE_WORKGROUP);
                    if (jA + 1 < 64) __hip_atomic_fetch_add(ip + jA + 1, (unsigned)(p0[4 * a + 3] * IMP_SCALE + 0.5f), __ATOMIC_RELAXED, __HIP_MEMORY_SCOPE_WORKGROUP);
                    if (jB + 1 < 64) __hip_atomic_fetch_add(ip + jB + 1, (unsigned)(p1[4 * a + 3] * IMP_SCALE + 0.5f), __ATOMIC_RELAXED, __HIP_MEMORY_SCOPE_WORKGROUP);
                }
            } else {
                float pmax = p0[0];
#pragma unroll
                for (int r = 1; r < 16; ++r) pmax = fmaxf(pmax, p0[r]);
#pragma unroll
                for (int r = 0; r < 16; ++r) pmax = fmaxf(pmax, p1[r]);
                { auto rr = __builtin_amdgcn_permlane32_swap(__float_as_uint(pmax), __float_as_uint(pmax), false, false);
                  pmax = fmaxf(__uint_as_float(rr[0]), __uint_as_float(rr[1])); }
                pmax *= SC;
                if (MODE == M_SLC) pmax = sel ? pmax : -__builtin_inff();
                float alpha = 1.f;
                if (!__all(pmax - m_reg <= DEFER_THR)) {
                    const float mn = fmaxf(m_reg, pmax);
                    alpha = __builtin_amdgcn_exp2f(m_reg - mn); m_reg = mn;
                    if (PASS == 0) {
                        if (hi == 0) al_l[r32] = alpha;
                        asm volatile("s_waitcnt lgkmcnt(0)" ::: "memory");
#pragma unroll
                        for (int r = 0; r < 16; ++r) { const float av = al_l[crow(r, hi)];
#pragma unroll
                            for (int d = 0; d < 4; ++d) o[d][r] *= av; }
                    }
                }
                const float mneg = (MODE == M_SLC && !sel) ? -__builtin_inff() : -m_reg;
                float ps = 0.f;
#pragma unroll
                for (int r = 0; r < 16; ++r) { p0[r] = __builtin_amdgcn_exp2f(fmaf(p0[r], SC, mneg)); p1[r] = __builtin_amdgcn_exp2f(fmaf(p1[r], SC, mneg)); ps += p0[r] + p1[r]; }
                { auto rr = __builtin_amdgcn_permlane32_swap(__float_as_uint(ps), __float_as_uint(ps), false, false);
                  ps = __uint_as_float(rr[0]) + __uint_as_float(rr[1]); }
                l_reg = l_reg * alpha + ps;
            }
            if (PASS != 1) {
                bf16x8 pa0, pa1, pa2, pa3;
                pack_p(p0, p1, pa0, pa1, pa2, pa3);
                pv_tile(o, vb0, pa0, pa1, pa2, pa3);
            }
        }
        if (i + 1 < nt) { AT_WRITE(bf ^ 1); if (i + 2 < nt) AT_LOAD(AT_TILE(i + 2)); }
        BAR_LDS();
    }
    __builtin_amdgcn_s_setprio(0);
#undef AT_LOAD
#undef AT_WRITE
#undef AT_TILE
}

__device__ __forceinline__ void mask_half(f32x16& p, int hi, int lo, int len, int base) {
    const float NEG = -__builtin_inff(); const int b = base + 4 * hi - lo; const unsigned ul = (unsigned)(len < 0 ? 0 : len);
#pragma unroll
    for (int r = 0; r < 16; ++r) { const int c = (r & 3) + 8 * (r >> 2); if ((unsigned)(c + b) >= ul) p[r] = NEG; }
}
#define PK4H(P, B_, OUT) do { unsigned a0 = cvtpk(P[B_+0], P[B_+1]), a1 = cvtpk(P[B_+2], P[B_+3]); \
        unsigned b0 = cvtpk(P[B_+4], P[B_+5]), b1 = cvtpk(P[B_+6], P[B_+7]); \
        auto r0 = __builtin_amdgcn_permlane32_swap(a0, b0, false, false); auto r1 = __builtin_amdgcn_permlane32_swap(a1, b1, false, false); \
        u32x4 w = {r0[0], r1[0], r0[1], r1[1]}; OUT = *reinterpret_cast<bf16x8*>(&w); } while (0)
template <int MODE>
__device__ __forceinline__ void attn_loop_h(LAS char* lds, const bf16_t* Kg, const bf16_t* Vg, int ldkv, const float* ckg, int t_lo, int t_hi,
                                            const bf16x8 (&qr)[8], const LaneCtx& cx, f32x16 (&o)[4], float& m_reg, float& l_reg) {
    const int tid = otid(), wid = __builtin_amdgcn_readfirstlane(tid >> 6), lane = tid & 63, r32 = lane & 31, hi = lane >> 5;
    const int sr = tid >> 4, sc = (tid & 15) * 8;
    const int kws = KSWZ(sr, sc * 2), vst0 = v_st(sr, sc), vst1 = v_st(32 + sr, sc);
    bf16x8 sk0, sk1, sv0, sv1; float sck = 0.f;
    const unsigned soff = (unsigned)(sr * ldkv + sc);
    const int nt = t_hi - t_lo;
    LAS unsigned* tflag = (LAS unsigned*)(lds + OFF_CK + 1024);
  for (int pass = 0; ; ++pass) {
    l_reg = 0.f;
#pragma unroll
    for (int d = 0; d < 4; ++d)
#pragma unroll
        for (int r = 0; r < 16; ++r) o[d][r] = 0.f;
#define AT_LOAD(t) do { const bf16_t* kt_ = Kg + (size_t)(64 * (t)) * ldkv; const bf16_t* kt2_ = kt_ + (size_t)32 * ldkv; sk0 = *(const bf16x8*)(kt_ + soff); sk1 = *(const bf16x8*)(kt2_ + soff); \
        { const bf16_t* vt_ = Vg + (size_t)(64 * (t)) * ldkv; const bf16_t* vt2_ = vt_ + (size_t)32 * ldkv; sv0 = *(const bf16x8*)(vt_ + soff); sv1 = *(const bf16x8*)(vt2_ + soff); } \
        if (MODE == M_FOX) { if (tid < 64) sck = ckg[64 * (t) + tid]; } } while (0)
#define AT_WRITE(bf) do { LAS char* b_ = lds + (bf) * 32768; *(LAS bf16x8*)(b_ + OFF_K + kws) = sk0; *(LAS bf16x8*)(b_ + OFF_K + kws + 32 * 256) = sk1; \
        *(LAS bf16x8*)(b_ + OFF_V + vst0) = sv0; *(LAS bf16x8*)(b_ + OFF_V + vst1) = sv1; \
        if (MODE == M_FOX) { if (tid < 64) ((LAS float*)(lds + OFF_CK))[(bf) * 64 + tid] = sck; } } while (0)
#define AT_TILE(i_) ((MODE == M_FOX) ? (t_hi - 1 - (i_)) : (t_lo + (i_)))
    if (nt > 0) AT_LOAD(AT_TILE(0));
    BAR_LDS();
    if (nt > 0) AT_WRITE(0);
    if (nt > 1) AT_LOAD(AT_TILE(1));
    if (MODE == M_FOX) { if (lane == 0) { ((LAS unsigned*)(lds + OFF_DEAD))[wid] = 0u; ((LAS unsigned*)(lds + OFF_DEAD))[8 + wid] = 0u; } }
    BAR_LDS();
    if (wid >= 4) __builtin_amdgcn_s_setprio(1);
    bool dead = false;
    for (int i = 0; i < nt; ++i) {
        const int t = AT_TILE(i), bf = i & 1;
        if (MODE == M_FOX) {
            if (i > 0) { const u32x4 d0_ = *(LAS const u32x4*)(lds + OFF_DEAD + ((i - 1) & 1) * 32), d1_ = *(LAS const u32x4*)(lds + OFF_DEAD + ((i - 1) & 1) * 32 + 16);
                if ((d0_.x & d0_.y & d0_.z & d0_.w & d1_.x & d1_.y & d1_.z & d1_.w) != 0u) break; }
            if (!dead) { const float ks_ = ((LAS const float*)(lds + OFF_FOXB))[t], cm_ = ((LAS const float*)(lds + OFF_FOXB))[64 + t];
                dead = __all(cx.qn * ks_ + cx.cq2 - cm_ - m_reg < -160.0f); }
            if (lane == 0) ((LAS unsigned*)(lds + OFF_DEAD))[(i & 1) * 8 + wid] = dead ? 1u : 0u;
        }
        LAS const char* K_lds = lds + bf * 32768 + OFF_K;
        const unsigned vb0 = (unsigned)(size_t)(lds + bf * 32768 + OFF_V) + (unsigned)v_rd_base(lane);
        LAS const float* ck_l = (LAS const float*)(lds + OFF_CK) + bf * 64;
        const int kb = 64 * t;
        bool act = true;
        if (MODE == M_FOX) act = (kb <= cx.wave_qmax) && !dead;
        if (act) {
            int lo, len;
            if (MODE == M_WIN) { lo = cx.qpos - 511 - kb; len = 512; }
            else if (MODE == M_FOX) { lo = -64; len = cx.qpos - kb + 65; }
            else { if (t < cx.cur) { lo = 0; len = 64; } else { lo = -64; len = cx.qpos - kb + 65; } }
            const bool need_mask = !__all(lo <= 0 && lo + len >= 64);
            bool sel = true;
            if (MODE == M_SLC) sel = ((t < 32 ? (cx.mlo >> t) : (cx.mhi >> (t - 32))) & 1u) != 0u;
            LAS const char* kbp[4];
#pragma unroll
            for (int dd = 0; dd < 4; ++dd) kbp[dd] = K_lds + KSWZ(r32, (dd * 16 + hi * 8) * 2);
#define KFRAG(d0, HALF_) (*(LAS const bf16x8*)(kbp[(d0) & 3] + ((d0) >> 2) * 128 + (HALF_) * 32 * 256))
            f32x16 p0, p1; bf16x8 pa0, pa1, pa2, pa3; float ps = 0.f;
            { const float tb = ((MODE == M_FOX) ? cx.cq2 : 0.f) - m_reg;
#pragma unroll
              for (int r = 0; r < 16; ++r) p1[r] = tb; }
            {   bf16x8 f0 = KFRAG(0, 0), f1 = KFRAG(1, 0);
#pragma unroll
                for (int k = 0; k < 8; ++k) { p0 = __builtin_amdgcn_mfma_f32_32x32x16_bf16((k & 1) ? f1 : f0, qr[k], k == 0 ? p1 : p0, 0, 0, 0);
                    if (k + 2 < 8) { if (k & 1) f1 = KFRAG(k + 2, 0); else f0 = KFRAG(k + 2, 0); } }
            }
            if (MODE == M_FOX) {
#pragma unroll
                for (int a = 0; a < 4; ++a) { const f32x4 c0 = *(LAS const f32x4*)(ck_l + 8 * a + 4 * hi);
#pragma unroll
                    for (int j = 0; j < 4; ++j) p0[4 * a + j] -= c0[j]; }
            }
            if (need_mask) mask_half(p0, hi, lo, len, 0);
            {   bf16x8 f0 = KFRAG(0, 1), f1 = KFRAG(1, 1);
                SBAR();
#pragma unroll
                for (int k = 0; k < 8; ++k) { p1 = __builtin_amdgcn_mfma_f32_32x32x16_bf16((k & 1) ? f1 : f0, qr[k], p1, 0, 0, 0);
                    if (k + 2 < 8) { if (k & 1) f1 = KFRAG(k + 2, 1); else f0 = KFRAG(k + 2, 1); }
                    p0[2 * k] = __builtin_amdgcn_exp2f(p0[2 * k]); p0[2 * k + 1] = __builtin_amdgcn_exp2f(p0[2 * k + 1]); ps += p0[2 * k] + p0[2 * k + 1];
                    if (k == 3) { PK4H(p0, 0, pa0); if (MODE == M_SLC) pa0 = sel ? pa0 : (bf16x8){0, 0, 0, 0, 0, 0, 0, 0}; }
                    if (k == 7) { PK4H(p0, 8, pa1); if (MODE == M_SLC) pa1 = sel ? pa1 : (bf16x8){0, 0, 0, 0, 0, 0, 0, 0}; }
                    SBAR(); }
            }
#undef KFRAG
            if (MODE == M_FOX) {
#pragma unroll
                for (int a = 0; a < 4; ++a) { const f32x4 c1 = *(LAS const f32x4*)(ck_l + 32 + 8 * a + 4 * hi);
#pragma unroll
                    for (int j = 0; j < 4; ++j) p1[4 * a + j] -= c1[j]; }
            }
            if (need_mask) mask_half(p1, hi, lo, len, 32);
            {
#define TRRD(dst, off) asm volatile("ds_read_b64_tr_b16 %0, %1 offset:%2" : "=&v"(dst) : "v"(vb0), "i"(off) : "memory")
#define PV_OFF(k) (v_rd_off(((k) & 7) >> 1, 2 * ((k) >> 3) + ((k) & 1), 0))
#define PV_A(k) ((((k) >> 3) == 0) ? (((k) & 1) ? pa1 : pa0) : (((k) & 1) ? pa3 : pa2))
#define PV_STEP(k, L, H, VALU_) do { \
                if ((k) + 1 < 16) asm volatile("s_waitcnt lgkmcnt(2)" ::: "memory"); else asm volatile("s_waitcnt lgkmcnt(0)" ::: "memory"); \
                SBAR(); \
                o[((k) & 7) >> 1] = __builtin_amdgcn_mfma_f32_32x32x16_bf16(PV_A(k), (bf16x8){L[0], L[1], L[2], L[3], H[0], H[1], H[2], H[3]}, o[((k) & 7) >> 1], 0, 0, 0); \
                if ((k) + 2 < 16) { TRRD(L, PV_OFF((k) + 2)); TRRD(H, PV_OFF((k) + 2) + 2048); } \
                if (VALU_) { constexpr int kk_ = (k) & 7; \
                    p1[2 * kk_] = __builtin_amdgcn_exp2f(p1[2 * kk_]); p1[2 * kk_ + 1] = __builtin_amdgcn_exp2f(p1[2 * kk_ + 1]); ps += p1[2 * kk_] + p1[2 * kk_ + 1]; \
                    if (kk_ == 3) { PK4H(p1, 0, pa2); if (MODE == M_SLC) pa2 = sel ? pa2 : (bf16x8){0, 0, 0, 0, 0, 0, 0, 0}; } \
                    if (kk_ == 7) { PK4H(p1, 8, pa3); if (MODE == M_SLC) pa3 = sel ? pa3 : (bf16x8){0, 0, 0, 0, 0, 0, 0, 0}; } } \
                SBAR(); } while (0)
                s16x4 la, ha, lb, hb;
                TRRD(la, PV_OFF(0)); TRRD(ha, PV_OFF(0) + 2048); TRRD(lb, PV_OFF(1)); TRRD(hb, PV_OFF(1) + 2048);
                SBAR();
                PV_STEP(0, la, ha, true);  PV_STEP(1, lb, hb, true);  PV_STEP(2, la, ha, true);  PV_STEP(3, lb, hb, true);
                PV_STEP(4, la, ha, true);  PV_STEP(5, lb, hb, true);  PV_STEP(6, la, ha, true);  PV_STEP(7, lb, hb, true);
                PV_STEP(8, la, ha, false); PV_STEP(9, lb, hb, false); PV_STEP(10, la, ha, false); PV_STEP(11, lb, hb, false);
                PV_STEP(12, la, ha, false); PV_STEP(13, lb, hb, false); PV_STEP(14, la, ha, false); PV_STEP(15, lb, hb, false);
#undef PV_STEP
#undef PV_A
#undef PV_OFF
#undef TRRD
            }
            { auto rr = __builtin_amdgcn_permlane32_swap(__float_as_uint(ps), __float_as_uint(ps), false, false);
              ps = __uint_as_float(rr[0]) + __uint_as_float(rr[1]); }
            if (MODE == M_SLC) ps = sel ? ps : 0.f;
            l_reg += ps;
        }
        if (i + 1 < nt) { AT_WRITE(bf ^ 1); if (i + 2 < nt) AT_LOAD(AT_TILE(i + 2)); }
        BAR_LDS();
    }
    __builtin_amdgcn_s_setprio(0);
    if (pass != 0) break;
    { const bool bad = !(l_reg > 1e-30f && l_reg < 1e30f);
      const bool trig = !__all(!bad);
      if (lane == 0) tflag[wid] = trig ? 1u : 0u; }
    BAR_LDS();
    { const u32x4 f0_ = *(LAS const u32x4*)tflag, f1_ = *(LAS const u32x4*)(tflag + 4);
      if ((f0_.x | f0_.y | f0_.z | f0_.w | f1_.x | f1_.y | f1_.z | f1_.w) == 0u) break; }
    { float ms = -1e30f, ls = 0.f; f32x16 od[4]; attn_loop<MODE, 1>(lds, Kg, Vg, ldkv, ckg, t_lo, t_hi, qr, cx, od, ms, ls); m_reg = ms > -1e29f ? ms : 0.f; }
  }
#undef AT_LOAD
#undef AT_WRITE
#undef AT_TILE
}
__device__ __forceinline__ void rescale_pa(bf16x8& pa, float alpha) {
    u32x4 w = *reinterpret_cast<u32x4*>(&pa);
#pragma unroll
    for (int j = 0; j < 4; ++j) { const float lo = __uint_as_float(w[j] << 16) * alpha, hi = __uint_as_float(w[j] & 0xffff0000u) * alpha; w[j] = cvtpk(lo, hi); }
    pa = *reinterpret_cast<bf16x8*>(&w);
}
template <int MODE, int HALF>
__device__ __forceinline__ void m_check0(const f32x16& p, bool sel, LAS float* al_l, int r32, int hi, f32x16 (&o)[4], float& m_reg, float& l_reg, float& ps, bf16x8& pa0, bf16x8& pa1) {
    constexpr float SC = 1.0f;
    float pm = p[0];
#pragma unroll
    for (int r = 1; r < 16; ++r) pm = fmaxf(pm, p[r]);
    { auto rr = __builtin_amdgcn_permlane32_swap(__float_as_uint(pm), __float_as_uint(pm), false, false);
      pm = fmaxf(__uint_as_float(rr[0]), __uint_as_float(rr[1])); }
    pm *= SC;
    if (MODE == M_SLC) pm = sel ? pm : -__builtin_inff();
    if (!__all(pm - m_reg <= DEFER_THR)) {
        const float mn = fmaxf(m_reg, pm);
        const float alpha = __builtin_amdgcn_exp2f(m_reg - mn); m_reg = mn;
        if (hi == 0) al_l[r32] = alpha;
        asm volatile("s_waitcnt lgkmcnt(0)" ::: "memory");
#pragma unroll
        for (int r = 0; r < 16; ++r) { const float av = al_l[crow(r, hi)];
#pragma unroll
            for (int d = 0; d < 4; ++d) o[d][r] *= av; }
        l_reg *= alpha;
        if (HALF == 1) { ps *= alpha; rescale_pa(pa0, alpha); rescale_pa(pa1, alpha); }
    }
}
template <int MODE>
__device__ __forceinline__ void attn_loop_h0(LAS char* lds, const bf16_t* Kg, const bf16_t* Vg, int ldkv, const float* ckg, int t_lo, int t_hi,
                                            const bf16x8 (&qr)[8], const LaneCtx& cx, f32x16 (&o)[4], float& m_reg, float& l_reg) {
    const int tid = otid(), wid = __builtin_amdgcn_readfirstlane(tid >> 6), lane = tid & 63, r32 = lane & 31, hi = lane >> 5;
    LAS float* al_l = (LAS float*)(lds + OFF_WS) + wid * 64;
    const int sr = tid >> 4, sc = (tid & 15) * 8;
    const int kws = KSWZ(sr, sc * 2), vst0 = v_st(sr, sc), vst1 = v_st(32 + sr, sc);
    bf16x8 sk0, sk1, sv0, sv1; float sck = 0.f;
    const unsigned soff = (unsigned)(sr * ldkv + sc);
    const int nt = t_hi - t_lo;
    constexpr float SC = 1.0f;
#define AT_LOAD(t) do { const bf16_t* kt_ = Kg + (size_t)(64 * (t)) * ldkv; const bf16_t* kt2_ = kt_ + (size_t)32 * ldkv; sk0 = *(const bf16x8*)(kt_ + soff); sk1 = *(const bf16x8*)(kt2_ + soff); \
        { const bf16_t* vt_ = Vg + (size_t)(64 * (t)) * ldkv; const bf16_t* vt2_ = vt_ + (size_t)32 * ldkv; sv0 = *(const bf16x8*)(vt_ + soff); sv1 = *(const bf16x8*)(vt2_ + soff); } \
        if (MODE == M_FOX) { if (tid < 64) sck = ckg[64 * (t) + tid]; } } while (0)
#define AT_WRITE(bf) do { LAS char* b_ = lds + (bf) * 32768; *(LAS bf16x8*)(b_ + OFF_K + kws) = sk0; *(LAS bf16x8*)(b_ + OFF_K + kws + 32 * 256) = sk1; \
        *(LAS bf16x8*)(b_ + OFF_V + vst0) = sv0; *(LAS bf16x8*)(b_ + OFF_V + vst1) = sv1; \
        if (MODE == M_FOX) { if (tid < 64) ((LAS float*)(lds + OFF_CK))[(bf) * 64 + tid] = sck; } } while (0)
#define AT_TILE(i_) ((MODE == M_FOX) ? (t_hi - 1 - (i_)) : (t_lo + (i_)))
    if (nt > 0) AT_LOAD(AT_TILE(0));
    BAR_LDS();
    if (nt > 0) AT_WRITE(0);
    if (nt > 1) AT_LOAD(AT_TILE(1));
    if (MODE == M_FOX) { if (lane == 0) { ((LAS unsigned*)(lds + OFF_DEAD))[wid] = 0u; ((LAS unsigned*)(lds + OFF_DEAD))[8 + wid] = 0u; } }
    BAR_LDS();
    if (wid >= 4) __builtin_amdgcn_s_setprio(1);
    bool dead = false;
    for (int i = 0; i < nt; ++i) {
        const int t = AT_TILE(i), bf = i & 1;
        if (MODE == M_FOX) {
            if (i > 0) { const u32x4 d0_ = *(LAS const u32x4*)(lds + OFF_DEAD + ((i - 1) & 1) * 32), d1_ = *(LAS const u32x4*)(lds + OFF_DEAD + ((i - 1) & 1) * 32 + 16);
                if ((d0_.x & d0_.y & d0_.z & d0_.w & d1_.x & d1_.y & d1_.z & d1_.w) != 0u) break; }
            if (!dead) { const float ks_ = ((LAS const float*)(lds + OFF_FOXB))[t], cm_ = ((LAS const float*)(lds + OFF_FOXB))[64 + t];
                dead = __all(cx.qn * ks_ + cx.cq2 - cm_ - m_reg < -160.0f); }
            if (lane == 0) ((LAS unsigned*)(lds + OFF_DEAD))[(i & 1) * 8 + wid] = dead ? 1u : 0u;
        }
        LAS const char* K_lds = lds + bf * 32768 + OFF_K;
        const unsigned vb0 = (unsigned)(size_t)(lds + bf * 32768 + OFF_V) + (unsigned)v_rd_base(lane);
        LAS const float* ck_l = (LAS const float*)(lds + OFF_CK) + bf * 64;
        const int kb = 64 * t;
        bool act = true;
        if (MODE == M_FOX) act = (kb <= cx.wave_qmax) && !dead;
        if (act) {
            int lo, len;
            if (MODE == M_WIN) { lo = cx.qpos - 511 - kb; len = 512; }
            else if (MODE == M_FOX) { lo = -64; len = cx.qpos - kb + 65; }
            else { if (t < cx.cur) { lo = 0; len = 64; } else { lo = -64; len = cx.qpos - kb + 65; } }
            const bool need_mask = !__all(lo <= 0 && lo + len >= 64);
            bool sel = true;
            if (MODE == M_SLC) sel = ((t < 32 ? (cx.mlo >> t) : (cx.mhi >> (t - 32))) & 1u) != 0u;
            LAS const char* kbp[4];
#pragma unroll
            for (int dd = 0; dd < 4; ++dd) kbp[dd] = K_lds + KSWZ(r32, (dd * 16 + hi * 8) * 2);
#define KFRAG(d0, HALF_) (*(LAS const bf16x8*)(kbp[(d0) & 3] + ((d0) >> 2) * 128 + (HALF_) * 32 * 256))
            f32x16 p0, p1; bf16x8 pa0, pa1, pa2, pa3; float ps = 0.f;
            {   bf16x8 f0 = KFRAG(0, 0), f1 = KFRAG(1, 0);
#pragma unroll
                for (int r = 0; r < 16; ++r) p0[r] = 0.f;
#pragma unroll
                for (int k = 0; k < 8; ++k) { p0 = __builtin_amdgcn_mfma_f32_32x32x16_bf16((k & 1) ? f1 : f0, qr[k], p0, 0, 0, 0);
                    if (k + 2 < 8) { if (k & 1) f1 = KFRAG(k + 2, 0); else f0 = KFRAG(k + 2, 0); } }
            }
            if (MODE == M_FOX) {
#pragma unroll
                for (int a = 0; a < 4; ++a) { const f32x4 c0 = *(LAS const f32x4*)(ck_l + 8 * a + 4 * hi);
#pragma unroll
                    for (int j = 0; j < 4; ++j) p0[4 * a + j] += cx.cq2 - c0[j]; }
            }
            if (need_mask) mask_half(p0, hi, lo, len, 0);
            m_check0<MODE, 0>(p0, sel, al_l, r32, hi, o, m_reg, l_reg, ps, pa0, pa1);
            float mneg = (MODE == M_SLC && !sel) ? -__builtin_inff() : -m_reg;
            {   bf16x8 f0 = KFRAG(0, 1), f1 = KFRAG(1, 1);
#pragma unroll
                for (int r = 0; r < 16; ++r) p1[r] = 0.f;
                SBAR();
#pragma unroll
                for (int k = 0; k < 8; ++k) { p1 = __builtin_amdgcn_mfma_f32_32x32x16_bf16((k & 1) ? f1 : f0, qr[k], p1, 0, 0, 0);
                    if (k + 2 < 8) { if (k & 1) f1 = KFRAG(k + 2, 1); else f0 = KFRAG(k + 2, 1); }
                    p0[2 * k] = __builtin_amdgcn_exp2f(fmaf(p0[2 * k], SC, mneg)); p0[2 * k + 1] = __builtin_amdgcn_exp2f(fmaf(p0[2 * k + 1], SC, mneg)); ps += p0[2 * k] + p0[2 * k + 1];
                    if (k == 3) PK4H(p0, 0, pa0);
                    if (k == 7) PK4H(p0, 8, pa1);
                    SBAR(); }
            }
#undef KFRAG
            if (MODE == M_FOX) {
#pragma unroll
                for (int a = 0; a < 4; ++a) { const f32x4 c1 = *(LAS const f32x4*)(ck_l + 32 + 8 * a + 4 * hi);
#pragma unroll
                    for (int j = 0; j < 4; ++j) p1[4 * a + j] += cx.cq2 - c1[j]; }
            }
            if (need_mask) mask_half(p1, hi, lo, len, 32);
            m_check0<MODE, 1>(p1, sel, al_l, r32, hi, o, m_reg, l_reg, ps, pa0, pa1);
            mneg = (MODE == M_SLC && !sel) ? -__builtin_inff() : -m_reg;
            {
#define TRRD(dst, off) asm volatile("ds_read_b64_tr_b16 %0, %1 offset:%2" : "=&v"(dst) : "v"(vb0), "i"(off) : "memory")
#define PV_OFF(k) (v_rd_off(((k) & 7) >> 1, 2 * ((k) >> 3) + ((k) & 1), 0))
#define PV_A(k) ((((k) >> 3) == 0) ? (((k) & 1) ? pa1 : pa0) : (((k) & 1) ? pa3 : pa2))
#define PV_STEP(k, L, H, VALU_) do { \
                if ((k) + 1 < 16) asm volatile("s_waitcnt lgkmcnt(2)" ::: "memory"); else asm volatile("s_waitcnt lgkmcnt(0)" ::: "memory"); \
                SBAR(); \
                o[((k) & 7) >> 1] = __builtin_amdgcn_mfma_f32_32x32x16_bf16(PV_A(k), (bf16x8){L[0], L[1], L[2], L[3], H[0], H[1], H[2], H[3]}, o[((k) & 7) >> 1], 0, 0, 0); \
                if ((k) + 2 < 16) { TRRD(L, PV_OFF((k) + 2)); TRRD(H, PV_OFF((k) + 2) + 2048); } \
                if (VALU_) { constexpr int kk_ = (k) & 7; \
                    p1[2 * kk_] = __builtin_amdgcn_exp2f(fmaf(p1[2 * kk_], SC, mneg)); p1[2 * kk_ + 1] = __builtin_amdgcn_exp2f(fmaf(p1[2 * kk_ + 1], SC, mneg)); ps += p1[2 * kk_] + p1[2 * kk_ + 1]; \
                    if (kk_ == 3) PK4H(p1, 0, pa2); \
                    if (kk_ == 7) PK4H(p1, 8, pa3); } \
                SBAR(); } while (0)
                s16x4 la, ha, lb, hb;
                TRRD(la, PV_OFF(0)); TRRD(ha, PV_OFF(0) + 2048); TRRD(lb, PV_OFF(1)); TRRD(hb, PV_OFF(1) + 2048);
                SBAR();
                PV_STEP(0, la, ha, true);  PV_STEP(1, lb, hb, true);  PV_STEP(2, la, ha, true);  PV_STEP(3, lb, hb, true);
                PV_STEP(4, la, ha, true);  PV_STEP(5, lb, hb, true);  PV_STEP(6, la, ha, true);  PV_STEP(7, lb, hb, true);
                PV_STEP(8, la, ha, false); PV_STEP(9, lb, hb, false); PV_STEP(10, la, ha, false); PV_STEP(11, lb, hb, false);
                PV_STEP(12, la, ha, false); PV_STEP(13, lb, hb, false); PV_STEP(14, la, ha, false); PV_STEP(15, lb, hb, false);
#undef PV_STEP
#undef PV_A
#undef PV_OFF
#undef TRRD
            }
            { auto rr = __builtin_amdgcn_permlane32_swap(__float_as_uint(ps), __float_as_uint(ps), false, false);
              ps = __uint_as_float(rr[0]) + __uint_as_float(rr[1]); }
            l_reg += ps;
        }
        if (i + 1 < nt) { AT_WRITE(bf ^ 1); if (i + 2 < nt) AT_LOAD(AT_TILE(i + 2)); }
        BAR_LDS();
    }
    __builtin_amdgcn_s_setprio(0);
#undef AT_LOAD
#undef AT_WRITE
#undef AT_TILE
}
#undef PK4H

#define DPPX(v, ctrl) ((unsigned)__builtin_amdgcn_update_dpp(0, (int)(v), (ctrl), 0xF, 0xF, true))
__device__ __forceinline__ void attn_store(LAS char* lds, const f32x16 (&o)[4], float rowscale, bf16_t* outbase, unsigned rowstride) {
    const int tid = otid(), wid = __builtin_amdgcn_readfirstlane(tid >> 6), lane = tid & 63, r32 = lane & 31, hi = lane >> 5;
    LAS float* li_l = (LAS float*)(lds + OFF_WS) + wid * 64 + 32;
    if (hi == 0) li_l[r32] = rowscale;
    asm volatile("s_waitcnt lgkmcnt(0)" ::: "memory");
    float f[16];
#pragma unroll
    for (int r = 0; r < 16; ++r) f[r] = li_l[crow(r, hi)];
    const bool b0 = (lane & 1) != 0, b1 = (lane & 2) != 0, b2 = (lane & 4) != 0;
    const int j = lane & 7;
    bf16_t* p0 = outbase + (size_t)crow(j, hi) * rowstride + (r32 & 24);
#pragma unroll
    for (int d0 = 0; d0 < 4; ++d0) {
        unsigned P[8];
#pragma unroll
        for (int rp = 0; rp < 8; ++rp) { const float a = o[d0][2 * rp] * f[2 * rp], b = o[d0][2 * rp + 1] * f[2 * rp + 1];
            const float snd = b0 ? a : b;
            const float rcv = __uint_as_float(DPPX(__float_as_uint(snd), 0xB1));
            P[rp] = cvtpk(b0 ? rcv : a, b0 ? b : rcv); }
        unsigned I[4][2];
#pragma unroll
        for (int q = 0; q < 4; ++q) { const unsigned snd = b1 ? P[2 * q] : P[2 * q + 1];
            const unsigned rcv = DPPX(snd, 0x4E);
            I[q][0] = b1 ? rcv : P[2 * q]; I[q][1] = b1 ? P[2 * q + 1] : rcv; }
#pragma unroll
        for (int h = 0; h < 2; ++h) { const unsigned s0 = b2 ? I[2 * h][0] : I[2 * h + 1][0], s1 = b2 ? I[2 * h][1] : I[2 * h + 1][1];
            const unsigned r0 = DPPX(DPPX(s0, 0x1B), 0x141), r1 = DPPX(DPPX(s1, 0x1B), 0x141);
            u32x4 w;
            w.x = b2 ? r0 : I[2 * h][0]; w.y = b2 ? r1 : I[2 * h][1]; w.z = b2 ? I[2 * h + 1][0] : r0; w.w = b2 ? I[2 * h + 1][1] : r1;
            *(u32x4*)(p0 + (size_t)(16 * h) * rowstride + d0 * 32) = w; }
    }
}
#undef DPPX
}
#ifndef PT_MODES
#define PT_MODES 7
#endif
#if PT_MODES & 1
#define PTL_WIN at::attn_loop_h<at::M_WIN>
#else
#define PTL_WIN at::attn_loop<at::M_WIN, 0>
#endif
#if PT_MODES & 2
#define PTL_SLC at::attn_loop_h<at::M_SLC>
#else
#define PTL_SLC at::attn_loop<at::M_SLC, 0>
#endif
#if PT_MODES & 4
#define PTL_FOX at::attn_loop_h0<at::M_FOX>
#else
#define PTL_FOX at::attn_loop<at::M_FOX, 0>
#endif

struct Params { const float* in[20]; float* out; unsigned char* ws; int ph_lo, ph_hi; };
enum { I_X = 0, I_NORM1, I_WIN, I_PE, I_CW1, I_CW2, I_POOLW, I_POOLS, I_FB, I_MIXG, I_WOUT, I_NORM2, I_FWG, I_FWU, I_FWD, I_ROUTER, I_MWG, I_MWU, I_MWD, I_FNORM };

__device__ __forceinline__ float bf2f(bf16_t v) { return __uint_as_float(((unsigned)v) << 16); }
__device__ __forceinline__ float sigmoidf_(float z) { return 1.0f / (1.0f + __expf(-z)); }

__device__ __forceinline__ void nsa_item(LAS char* lds, const Params& P, int bg, int qb) {
    using namespace at;
    const int tid = otid(), wid = __builtin_amdgcn_readfirstlane(tid >> 6), lane = tid & 63, r32 = lane & 31, hi = lane >> 5;
    const int b = bg >> 1, g = bg & 1, head = g * 4 + (wid >> 1), qi = (wid & 1) * 32 + r32;
    const bf16_t* proj = (const bf16_t*)(P.ws + WS_PROJ);
    const float* gf = (const float*)(P.ws + WS_GF);
    bf16_t* mix = (bf16_t*)(P.ws + WS_MIX);
    const bf16_t* kcb = (const bf16_t*)(P.ws + WS_KC);
    const size_t trow = (size_t)b * SEQ + 64 * qb + qi;
    LaneCtx cx; cx.qpos = 64 * qb + qi; cx.nvis = cx.qpos >= 31 ? (cx.qpos - 31) / 16 + 1 : 0; cx.mlo = 0; cx.mhi = 0; cx.cur = qb; cx.cq2 = 0.f; cx.m_fin = 0.f; cx.inv_l = 0.f; cx.wave_qmax = 0; cx.qn = 0.f;
    bf16x8 qr[8];
    { const bf16_t* qp = proj + trow * NPROJ + PC_Q + head * 128 + hi * 8;
#pragma unroll
      for (int d0 = 0; d0 < 8; ++d0) qr[d0] = *(const bf16x8*)(qp + d0 * 16); }
    const float g0 = sigmoidf_(gf[trow * 32 + head * 3 + 0]), g1 = sigmoidf_(gf[trow * 32 + head * 3 + 1]), g2 = sigmoidf_(gf[trow * 32 + head * 3 + 2]);
    bf16_t* outbase = mix + ((size_t)b * SEQ + 64 * qb + (wid & 1) * 32) * 4096 + head * 128;
    f32x16 o[4];
    float m_reg, l_reg;
    const int ncv = 4 * qb + 3;
    const int ntc = (ncv + 63) / 64;
    const bf16_t* Kc = kcb + (size_t)(0 * 8 + bg) * 256 * 128; const bf16_t* Vc = kcb + (size_t)(1 * 8 + bg) * 256 * 128;
    m_reg = -1e30f; l_reg = 0.f;
    attn_loop<M_CMP, 1>(lds, Kc, Vc, 128, nullptr, 0, ntc, qr, cx, o, m_reg, l_reg);
    cx.m_fin = m_reg; cx.inv_l = l_reg > 0.f ? 1.0f / l_reg : 0.f;
    for (int i = tid; i < 64 * 65; i += 512) ((LAS unsigned*)(lds + OFF_IMP))[i] = 0u;
#pragma unroll
    for (int d = 0; d < 4; ++d)
#pragma unroll
        for (int r = 0; r < 16; ++r) o[d][r] = 0.f;
    attn_loop<M_CMP, 2>(lds, Kc, Vc, 128, nullptr, 0, ntc, qr, cx, o, m_reg, l_reg);
    attn_store(lds, o, g0, outbase, 4096u);
    {
        LAS unsigned* IMP = (LAS unsigned*)(lds + OFF_IMP); LAS unsigned* MSK = (LAS unsigned*)(lds + OFF_MASK);
        for (int idx = tid; idx < 4096; idx += 512) { const int q = idx >> 6, j = idx & 63;
            const unsigned v = IMP[q * 65 + j];
            const bool forced = (j == 0) || (j == qb) || (j == qb - 1), valid = j <= qb;
            IMP[q * 65 + j] = forced ? 0xFFFFFFFFu : (valid ? v + 1u : 0u); }
        BAR_LDS();
        const int q = tid >> 3, jg = tid & 7;
        unsigned mv[8]; int rank[8];
#pragma unroll
        for (int jj = 0; jj < 8; ++jj) { mv[jj] = IMP[q * 65 + jg * 8 + jj]; rank[jj] = 0; }
        for (int j2 = 0; j2 < 64; ++j2) { const unsigned x = IMP[q * 65 + j2];
#pragma unroll
            for (int jj = 0; jj < 8; ++jj) rank[jj] += (x > mv[jj] || (x == mv[jj] && j2 < jg * 8 + jj)) ? 1 : 0; }
        unsigned bits = 0;
#pragma unroll
        for (int jj = 0; jj < 8; ++jj) bits |= (rank[jj] < 16 ? 1u : 0u) << jj;
        unsigned lo = jg < 4 ? bits << (8 * jg) : 0u, hw = jg >= 4 ? bits << (8 * (jg - 4)) : 0u;
        lo |= __shfl_xor(lo, 1); hw |= __shfl_xor(hw, 1); lo |= __shfl_xor(lo, 2); hw |= __shfl_xor(hw, 2); lo |= __shfl_xor(lo, 4); hw |= __shfl_xor(hw, 4);
        if (jg == 0) { MSK[2 * q] = lo; MSK[2 * q + 1] = hw; }
        BAR_LDS();
        cx.mlo = MSK[2 * qi]; cx.mhi = MSK[2 * qi + 1];
    }
#pragma unroll
    for (int d = 0; d < 4; ++d)
#pragma unroll
        for (int r = 0; r < 16; ++r) o[d][r] = 0.f;
    m_reg = REF0; l_reg = 0.f;
    { const bf16_t* Ks = proj + (size_t)b * SEQ * NPROJ + PC_KS + g * 128; const bf16_t* Vs = proj + (size_t)b * SEQ * NPROJ + PC_VS + g * 128;
      PTL_SLC(lds, Ks, Vs, NPROJ, nullptr, 0, qb + 1, qr, cx, o, m_reg, l_reg); }
    attn_store(lds, o, l_reg > 0.f ? g1 / l_reg : 0.f, outbase + 1024, 4096u);
#pragma unroll
    for (int d = 0; d < 4; ++d)
#pragma unroll
        for (int r = 0; r < 16; ++r) o[d][r] = 0.f;
    m_reg = REF0; l_reg = 0.f;
    { const bf16_t* Kw = proj + (size_t)b * SEQ * NPROJ + PC_KW + g * 128; const bf16_t* Vw = proj + (size_t)b * SEQ * NPROJ + PC_VW + g * 128;
      PTL_WIN(lds, Kw, Vw, NPROJ, nullptr, qb >= 8 ? qb - 8 : 0, qb + 1, qr, cx, o, m_reg, l_reg); }
    attn_store(lds, o, l_reg > 0.f ? g2 / l_reg : 0.f, outbase + 2048, 4096u);
    BAR_LDS();
}

__device__ __forceinline__ void fox_item(LAS char* lds, const Params& P, int bh, int qb) {
    using namespace at;
    const int tid = otid(), wid = __builtin_amdgcn_readfirstlane(tid >> 6), lane = tid & 63, r32 = lane & 31, hi = lane >> 5;
    const int b = bh >> 2, h = bh & 3;
    const bf16_t* proj = (const bf16_t*)(P.ws + WS_PROJ);
    const float* cum = (const float*)(P.ws + WS_CUM) + (size_t)bh * SEQ;
    bf16_t* mix = (bf16_t*)(P.ws + WS_MIX);
    const int qpos = 256 * qb + wid * 32 + r32;
    const size_t trow = (size_t)b * SEQ + qpos;
    LaneCtx cx; cx.qpos = qpos; cx.nvis = 0; cx.mlo = 0; cx.mhi = 0; cx.cur = 0; cx.cq2 = cum[qpos]; cx.m_fin = 0.f; cx.inv_l = 0.f; cx.wave_qmax = 256 * qb + wid * 32 + 31; cx.qn = 0.f;
    bf16x8 qr[8];
    { const bf16_t* qp = proj + trow * NPROJ + PC_FQ + h * 128 + hi * 8;
#pragma unroll
      for (int d0 = 0; d0 < 8; ++d0) qr[d0] = *(const bf16x8*)(qp + d0 * 16); }
    { float ss = 0.f;
#pragma unroll
      for (int d0 = 0; d0 < 8; ++d0)
#pragma unroll
          for (int e = 0; e < 8; ++e) { const float v = bf2f((bf16_t)qr[d0][e]); ss += v * v; }
      auto rr = __builtin_amdgcn_permlane32_swap(__float_as_uint(ss), __float_as_uint(ss), false, false);
      cx.qn = sqrtf(__uint_as_float(rr[0]) + __uint_as_float(rr[1])); }
    if (tid < 64) { const float* ksg = (const float*)(P.ws + WS_KSG) + bh * 64;
        float kx = ksg[tid];
#pragma unroll
        for (int o = 1; o < 64; o <<= 1) { const float t2 = __shfl_up(kx, o); if (lane >= o) kx = fmaxf(kx, t2); }
        ((LAS float*)(lds + OFF_FOXB))[tid] = kx * 1.01f;
        ((LAS float*)(lds + OFF_FOXB))[64 + tid] = cum[64 * tid + 63]; }
    f32x16 o[4];
#pragma unroll
    for (int d = 0; d < 4; ++d)
#pragma unroll
        for (int r = 0; r < 16; ++r) o[d][r] = 0.f;
    float m_reg = 0.f, l_reg = 0.f;
    const bf16_t* Kf = proj + (size_t)b * SEQ * NPROJ + PC_FK + h * 128; const bf16_t* Vf = proj + (size_t)b * SEQ * NPROJ + PC_FV + h * 128;
    PTL_FOX(lds, Kf, Vf, NPROJ, cum, 0, 4 * (qb + 1), qr, cx, o, m_reg, l_reg);
    bf16_t* outbase = mix + ((size_t)b * SEQ + 256 * qb + wid * 32) * 4096 + 3584 + h * 128;
    attn_store(lds, o, l_reg > 0.f ? 1.0f / l_reg : 0.f, outbase, 4096u);
    BAR_LDS();
}

enum { XK_ID = 0, XK_INPROJ = 1, XK_GU = 2 };
__device__ __forceinline__ void xpose_tile(const float* src0, const float* src1, int ldsrc, int kind, const float* scale, bf16_t* dst, int K, int k0, int n0) {
    const int lane = otid() & 63;
    const int np = n0 + lane;
    const float* sp = src0; int col = np;
    if (kind == XK_INPROJ) {
        if (np < 2560) col = np; else if (np < 3072) col = np - 2560 + 2584; else if (np < 4608) col = np - 3072 + 3096; else if (np < 4632) col = np - 4608 + 2560; else if (np < 4636) col = np; else col = -1;
    } else if (kind == XK_GU) { const int pn = np >> 8, rr = np & 255; col = pn * 128 + (rr & 127); sp = (rr >= 128) ? src1 : src0; }
    const bool ok = col >= 0; if (!ok) col = 0;
    const float* p = sp + (size_t)k0 * ldsrc + col;
    float v[64];
#pragma unroll
    for (int kk = 0; kk < 64; ++kk) v[kk] = p[(size_t)kk * ldsrc];
    if (scale) {
#pragma unroll
        for (int kk = 0; kk < 64; ++kk) v[kk] *= scale[k0 + kk]; }
    bf16_t* dp = dst + (size_t)np * K + k0;
#pragma unroll
    for (int c = 0; c < 8; ++c) { u32x4 w;
        w.x = pg8::cvt_pk_bf16(v[c * 8 + 0], v[c * 8 + 1]); w.y = pg8::cvt_pk_bf16(v[c * 8 + 2], v[c * 8 + 3]); w.z = pg8::cvt_pk_bf16(v[c * 8 + 4], v[c * 8 + 5]); w.w = pg8::cvt_pk_bf16(v[c * 8 + 6], v[c * 8 + 7]);
        if (!ok) w = (u32x4){0u, 0u, 0u, 0u};
        *(u32x4*)(dp + c * 8) = w; }
}
struct XJob { const float* s0; const float* s1; const float* scale; bf16_t* dst; int ld, kind, K, k0, n0, f8; };
constexpr int XP = 262;
constexpr int XP8 = 260;
constexpr float WSCALE8 = 64.f;
__device__ __forceinline__ void xload(const XJob& j, int wid, int lane, f32x4 (&v)[8]) {
    const int np = j.n0 + 4 * lane;
    const float* sp = j.s0; int col = np;
    if (j.kind == XK_INPROJ) {
        if (np < 2560) col = np; else if (np < 3072) col = np - 2560 + 2584; else if (np < 4608) col = np - 3072 + 3096; else if (np < 4632) col = np - 4608 + 2560; else if (np < 4636) col = np; else col = -1;
    } else if (j.kind == XK_GU) { const int pn = np >> 8, rr = np & 255; col = pn * 128 + (rr & 127); sp = (rr >= 128) ? j.s1 : j.s0; }
    const bool ok = col >= 0; if (!ok) col = 0;
    const float* p = sp + (size_t)(j.k0 + wid) * j.ld + col;
#pragma unroll
    for (int r = 0; r < 8; ++r) { v[r] = __builtin_nontemporal_load((const f32x4*)(p + (size_t)(8 * r) * j.ld)); }
    if (!ok) {
#pragma unroll
        for (int r = 0; r < 8; ++r) v[r] = (f32x4){0.f, 0.f, 0.f, 0.f}; }
}
__device__ __forceinline__ void xstore_lds(LAS unsigned char* lds, const XJob& j, int wid, int lane, const f32x4 (&v)[8]) {
    LAS unsigned* tl = (LAS unsigned*)lds;
#pragma unroll
    for (int r = 0; r < 8; ++r) { const int k = wid + 8 * r; float sc = j.scale ? j.scale[j.k0 + k] : 1.0f;
        if (j.f8) { sc *= WSCALE8; tl[k * (XP8 / 4) + lane] = pg8::pack_fp8x4(v[r][0] * sc, v[r][1] * sc, v[r][2] * sc, v[r][3] * sc); }
        else { tl[k * (XP / 2) + 2 * lane] = pg8::cvt_pk_bf16(v[r][0] * sc, v[r][1] * sc); tl[k * (XP / 2) + 2 * lane + 1] = pg8::cvt_pk_bf16(v[r][2] * sc, v[r][3] * sc); } }
}
__device__ __forceinline__ void xwrite_out(LAS unsigned char* lds, const XJob& j, int tid) {
    if (j.f8) {
        LAS const unsigned char* tb = (LAS const unsigned char*)lds;
#pragma unroll
        for (int i = 0; i < 2; ++i) { const int c = tid + 512 * i, row = c >> 2, kc = c & 3;
            unsigned w[4];
#pragma unroll
            for (int q4 = 0; q4 < 4; ++q4) { unsigned x = 0;
#pragma unroll
                for (int q = 0; q < 4; ++q) x |= (unsigned)tb[(kc * 16 + q4 * 4 + q) * XP8 + row] << (8 * q);
                w[q4] = x; }
            *(u32x4*)((unsigned char*)j.dst + (size_t)(j.n0 + row) * j.K + j.k0 + kc * 16) = (u32x4){w[0], w[1], w[2], w[3]}; }
        return;
    }
    LAS const bf16_t* tl = (LAS const bf16_t*)lds;
#pragma unroll
    for (int i = 0; i < 4; ++i) { const int c = tid + 512 * i, row = c >> 3, kc = c & 7;
        unsigned short e[8];
#pragma unroll
        for (int q = 0; q < 8; ++q) e[q] = tl[(kc * 8 + q) * XP + row];
        u32x4 w; w.x = (unsigned)e[0] | ((unsigned)e[1] << 16); w.y = (unsigned)e[2] | ((unsigned)e[3] << 16); w.z = (unsigned)e[4] | ((unsigned)e[5] << 16); w.w = (unsigned)e[6] | ((unsigned)e[7] << 16);
        *(u32x4*)(j.dst + (size_t)(j.n0 + row) * j.K + j.k0 + kc * 8) = w; }
}
constexpr int BT0 = 4 * 32 * 19, BT1 = BT0 + 4 * 32 * 8, BT2 = BT1 + 2 * 32 * 44, BT3 = BT2 + 2 * 88 * 8, BT4 = BT3 + 16 * 32 * 28, BT5 = BT4 + 16 * 56 * 8;
__device__ __forceinline__ XJob xjob(const Params& P, int bt_) {
    const int bt = BT5 - 1 - bt_;
    unsigned char* ws = P.ws; XJob j;
    if (bt < BT0) { const int inst = bt / 608, r = bt % 608, kt = r & 31, nt = r >> 5;
        j = XJob{P.in[I_WIN] + (size_t)inst * DM * 4636, nullptr, P.in[I_NORM1] + inst * DM, INPROJ_FP8 ? (bf16_t*)(ws + WS_WIN + (size_t)inst * NPROJ * DM) : (bf16_t*)(ws + WS_WIN) + (size_t)inst * NPROJ * DM, 4636, XK_INPROJ, DM, kt * 64, nt * 256, INPROJ_FP8}; }
    else if (bt < BT1) { const int q = bt - BT0, inst = q / 256, r = q % 256, kt = r & 31, nt = r >> 5;
        j = XJob{P.in[I_WOUT] + (size_t)inst * DM * DM, nullptr, P.in[I_MIXG] + inst * DM, (bf16_t*)(ws + WS_WOUT) + (size_t)inst * DM * DM, DM, XK_ID, DM, kt * 64, nt * 256, 0}; }
    else if (bt < BT2) { const int q = bt - BT1, inst = q / 1408, r = q % 1408, kt = r & 31, nt = r >> 5;
        j = XJob{P.in[I_FWG] + (size_t)inst * DM * DFF, P.in[I_FWU] + (size_t)inst * DM * DFF, P.in[I_NORM2] + (2 * inst) * DM, (bf16_t*)(ws + WS_WFGU + (size_t)inst * 2 * DFF * DM), DFF, XK_GU, DM, kt * 64, nt * 256, 1}; }
    else if (bt < BT3) { const int q = bt - BT2, inst = q / 704, r = q % 704, kt = r % 88, nt = r / 88;
        j = XJob{P.in[I_FWD] + (size_t)inst * DFF * DM, nullptr, nullptr, (bf16_t*)(ws + WS_WFD + (size_t)inst * DM * DFF), DM, XK_ID, DFF, kt * 64, nt * 256, 1}; }
    else if (bt < BT4) { const int q = bt - BT3, inst = q / 896, r = q % 896, kt = r & 31, nt = r >> 5;
        j = XJob{P.in[I_MWG] + (size_t)inst * DM * DFE, P.in[I_MWU] + (size_t)inst * DM * DFE, P.in[I_NORM2] + (2 * (inst >> 3) + 1) * DM, (bf16_t*)(ws + WS_WMGU + (size_t)inst * 2 * DFE * DM), DFE, XK_GU, DM, kt * 64, nt * 256, 1}; }
    else { const int q = bt - BT4, inst = q / 448, r = q % 448, kt = r % 56, nt = r / 56;
        j = XJob{P.in[I_MWD] + (size_t)inst * DFE * DM, nullptr, nullptr, (bf16_t*)(ws + WS_WMD + (size_t)inst * DM * DFE), DM, XK_ID, DFE, kt * 64, nt * 256, 1}; }
    return j;
}
__device__ __forceinline__ void ph_prologue(LAS unsigned char* lds, const Params& P) {
    constexpr int T0 = 4 * 2432, T1 = T0 + 4 * 1024, T2 = T1 + 2 * 5632, T3 = T2 + 2 * 2816, T4 = T3 + 16 * 3584, T5 = T4 + 16 * 1792, T6 = T5 + 8 * 128, T7 = T6 + 8 * 4, T8 = T7 + 16 * 4;
    unsigned char* ws = P.ws;
    const int wid = __builtin_amdgcn_readfirstlane(otid() >> 6);
    for (int bb = obid(); bb < 256; bb += gridDim.x) {
        const int tid = otid(), inst = bb >> 5, n = (bb & 31) * 4 + (tid & 3), ks = tid >> 2;
        const float* pe = P.in[I_PE] + (size_t)inst * 4096 + ks * 32; const float* w1 = P.in[I_CW1] + (size_t)inst * 4096 * 128 + (size_t)ks * 32 * 128 + n;
        float s = 0.f;
#pragma unroll 8
        for (int k = 0; k < 32; ++k) s += pe[k] * w1[(size_t)k * 128];
        LAS float* red = (LAS float*)lds;
        red[(tid & 3) * 128 + ks] = s;
        __syncthreads();
        if (tid < 4) { float t = 0.f; for (int i = 0; i < 128; ++i) t += red[tid * 128 + i]; ((float*)(ws + WS_B1))[inst * 128 + (bb & 31) * 4 + tid] = t; }
        __syncthreads();
    }
    {
        const int lane = otid() & 63;
        auto cost = [](int it) { if (it < 512) { const int qb = it & 63; return (qb + 1) + (qb + 1 < 9 ? qb + 1 : 9) + 2 * ((4 * qb + 3 + 63) / 64) + 3; } else { const int qb = (it - 512) & 15; return 4 * (qb + 1) + 1; } };
        for (int i = obid() * 8 + wid; i < 768; i += gridDim.x * 8) {
            const int ci = cost(i); int rk = 0;
            for (int j = lane; j < 768; j += 64) { const int cj = cost(j); rk += (cj > ci || (cj == ci && j < i)) ? 1 : 0; }
#pragma unroll
            for (int o = 32; o >= 1; o >>= 1) rk += __shfl_xor(rk, o);
            if (lane == 0) ((int*)(ws + WS_ILIST))[rk] = i;
        }
    }
    {
        const int tid = otid(), lane = tid & 63; const int gs = (int)gridDim.x;
        int bt = obid(); f32x4 va[8], vb[8]; XJob ja, jb;
        if (bt < BT5) { ja = xjob(P, bt); xload(ja, wid, lane, va); }
        if (bt + gs < BT5) { jb = xjob(P, bt + gs); xload(jb, wid, lane, vb); }
        __syncthreads();
        __syncthreads();
        while (bt < BT5) {
            { XJob j = ja; xstore_lds(lds, j, wid, lane, va);
              if (bt + 2 * gs < BT5) { ja = xjob(P, bt + 2 * gs); xload(ja, wid, lane, va); }
              BAR_LDS(); xwrite_out(lds, j, tid); BAR_LDS(); }
            bt += gs; if (bt >= BT5) break;
            { XJob j = jb; xstore_lds(lds, j, wid, lane, vb);
              if (bt + 2 * gs < BT5) { jb = xjob(P, bt + 2 * gs); xload(jb, wid, lane, vb); }
              BAR_LDS(); xwrite_out(lds, j, tid); BAR_LDS(); }
            bt += gs;
        }
    }
    { const int tid = otid();
      for (int ch = obid() * 512 + tid; ch < 8 * 32 * 4 * 8 * 64; ch += gridDim.x * 512) {
          const int ln = ch & 63, dd = (ch >> 6) & 7, nb = (ch >> 9) & 3, l = (ch >> 11) & 31, inst = ch >> 16;
          const float* src = P.in[I_CW1] + ((size_t)inst * 4096 + l * 128 + dd * 16 + (ln >> 5) * 8) * 128 + nb * 32 + (ln & 31);
          float v[8];
#pragma unroll
          for (int e = 0; e < 8; ++e) v[e] = src[(size_t)e * 128];
          u32x4 w; w.x = pg8::cvt_pk_bf16(v[0], v[1]); w.y = pg8::cvt_pk_bf16(v[2], v[3]); w.z = pg8::cvt_pk_bf16(v[4], v[5]); w.w = pg8::cvt_pk_bf16(v[6], v[7]);
          ((u32x4*)(ws + WS_WC1))[ch] = w; } }
    { const int tid = otid();
      for (int ch = obid() * 512 + tid; ch < 16 * 4 * 8 * 64; ch += gridDim.x * 512) {
          const int ln = ch & 63, d0 = (ch >> 6) & 7, nb = (ch >> 9) & 3, inst = ch >> 11;
          const float* src = P.in[I_POOLW] + ((size_t)inst * 128 + d0 * 16 + (ln >> 5) * 8) * 128 + nb * 32 + (ln & 31);
          float v[8];
#pragma unroll
          for (int e = 0; e < 8; ++e) v[e] = src[(size_t)e * 128];
          u32x4 w; w.x = pg8::cvt_pk_bf16(v[0], v[1]); w.y = pg8::cvt_pk_bf16(v[2], v[3]); w.z = pg8::cvt_pk_bf16(v[4], v[5]); w.w = pg8::cvt_pk_bf16(v[6], v[7]);
          ((u32x4*)(ws + WS_WPOOL))[ch] = w; } }
    for (int tix = T5 + obid() * 8 + wid; tix < T8; tix += gridDim.x * 8) {
        if (false) {}
        else if (tix < T6) { }
        else if (tix < T7) { const int q = tix - T6, inst = q / 4, r = q % 4, kt = r / 2, nt = r % 2;
            xpose_tile(P.in[I_CW2] + (size_t)inst * 128 * 128, nullptr, 128, XK_ID, nullptr, (bf16_t*)(ws + WS_WC2) + (size_t)inst * 128 * 128, 128, kt * 64, nt * 64); }
        else { }
    }
}

#ifndef NRW
#define NRW 4
#endif
template <int MODE, bool XS = false>
__device__ __forceinline__ void ph_norm(LAS unsigned char* lds, const Params& P, const float* xsrc  , bf16_t* xb16  , bool combine, const float* gain, const float* router, float* outp, bool out8 = false) {
    const int tid = otid(), wid = __builtin_amdgcn_readfirstlane(tid >> 6), lane = tid & 63;
    constexpr int NR_ = (XS || MODE == 1) ? 2 : NRW;
    bf16_t* hb = (bf16_t*)(P.ws + WS_H);
    int* route = (int*)(P.ws + WS_ROUTE);
    const unsigned char* Y8 = (const unsigned char*)(P.ws + WS_MIX);
    LAS float* RT = (LAS float*)lds;
    LAS int* EL = (LAS int*)(lds + 65536);
    if (MODE == 1) { for (int i = tid; i < DM * 8 / 4; i += 512) ((LAS f32x4*)RT)[i] = ((const f32x4*)router)[i]; __syncthreads(); }
    f32x4 gfin[8];
    if (MODE == 2) {
#pragma unroll
        for (int j = 0; j < 8; ++j) gfin[j] = *(const f32x4*)(gain + j * 256 + lane * 4); }
    for (int rb = obid(); rb < NT / 64; rb += gridDim.x) {
        for (int s0 = 0; s0 < 8; s0 += NR_) {
            f32x4 xf[XS ? NR_ : 1][8]; u32x2 xr[XS ? 1 : NR_][8]; unsigned ya[NR_][8], yc[NR_][8]; int sl1[NR_], sl2[NR_]; float cw1[NR_], cw2[NR_];
#pragma unroll
            for (int q = 0; q < NR_; ++q) { const int row = rb * 64 + (s0 + q) * 8 + wid;
#pragma unroll
                for (int j = 0; j < 8; ++j) {
                    if (XS) xf[XS ? q : 0][j] = *(const f32x4*)(xsrc + (size_t)row * DM + j * 256 + lane * 4);
                    else xr[XS ? 0 : q][j] = *(const u32x2*)(xb16 + (size_t)row * DM + j * 256 + lane * 4); }
                if (combine) { sl1[q] = route[row * 8 + 4]; sl2[q] = route[row * 8 + 5]; cw1[q] = __int_as_float(route[row * 8 + 2]); cw2[q] = __int_as_float(route[row * 8 + 3]); } }
            if (combine) {
#pragma unroll
                for (int q = 0; q < NR_; ++q)
#pragma unroll
                    for (int j = 0; j < 8; ++j) { ya[q][j] = *(const unsigned*)(Y8 + (size_t)sl1[q] * DM + j * 256 + lane * 4); yc[q][j] = *(const unsigned*)(Y8 + (size_t)sl2[q] * DM + j * 256 + lane * 4); } }
#pragma unroll
          for (int q = 0; q < NR_; ++q) {
            const int s = s0 + q;
            const int row = rb * 64 + s * 8 + wid;
            f32x4 xv[8];
#pragma unroll
            for (int j = 0; j < 8; ++j) {
                if (XS) xv[j] = xf[XS ? q : 0][j];
                else { const u32x2 w = xr[XS ? 0 : q][j];
                    xv[j] = (f32x4){__uint_as_float(w.x << 16), __uint_as_float(w.x & 0xffff0000u), __uint_as_float(w.y << 16), __uint_as_float(w.y & 0xffff0000u)}; } }
            if (combine) {
                const float w1 = cw1[q], w2 = cw2[q];
#pragma unroll
                for (int j = 0; j < 8; ++j) { const unsigned a = ya[q][j], c = yc[q][j];
                    const f32x2 a0 = __builtin_amdgcn_cvt_pk_f32_fp8(a, false), a1 = __builtin_amdgcn_cvt_pk_f32_fp8(a, true), c0 = __builtin_amdgcn_cvt_pk_f32_fp8(c, false), c1 = __builtin_amdgcn_cvt_pk_f32_fp8(c, true);
                    xv[j][0] += w1 * a0[0] + w2 * c0[0]; xv[j][1] += w1 * a0[1] + w2 * c0[1]; xv[j][2] += w1 * a1[0] + w2 * c1[0]; xv[j][3] += w1 * a1[1] + w2 * c1[1]; }
                if (MODE != 2) {
#pragma unroll
                    for (int j = 0; j < 8; ++j) { u32x2 w; w.x = pg8::cvt_pk_bf16(xv[j][0], xv[j][1]); w.y = pg8::cvt_pk_bf16(xv[j][2], xv[j][3]); *(u32x2*)(xb16 + (size_t)row * DM + j * 256 + lane * 4) = w; } }
            }
            float ss = 0.f;
#pragma unroll
            for (int j = 0; j < 8; ++j) ss += (xv[j][0] * xv[j][0] + xv[j][1] * xv[j][1]) + (xv[j][2] * xv[j][2] + xv[j][3] * xv[j][3]);
#pragma unroll
            for (int o = 32; o >= 1; o >>= 1) ss += __shfl_xor(ss, o);
            const float rstd = 1.0f / sqrtf(ss * (1.0f / DM) + 1e-6f);
            if (MODE == 2) {
#pragma unroll
                for (int j = 0; j < 8; ++j) *(f32x4*)(outp + (size_t)row * DM + j * 256 + lane * 4) = xv[j] * rstd * gfin[j];
            } else {
#pragma unroll
                for (int j = 0; j < 8; ++j) {
                    if (out8) *(unsigned*)((unsigned char*)hb + (size_t)row * DM + j * 256 + lane * 4) = pg8::pack_fp8x4(xv[j][0] * rstd, xv[j][1] * rstd, xv[j][2] * rstd, xv[j][3] * rstd);
                    else { u32x2 w; w.x = pg8::cvt_pk_bf16(xv[j][0] * rstd, xv[j][1] * rstd); w.y = pg8::cvt_pk_bf16(xv[j][2] * rstd, xv[j][3] * rstd);
                        *(u32x2*)(hb + (size_t)row * DM + j * 256 + lane * 4) = w; } }
            }
            if (MODE == 1) {
                float lg[8];
#pragma unroll
                for (int e = 0; e < 8; ++e) lg[e] = 0.f;
#pragma unroll
                for (int j = 0; j < 8; ++j) { const f32x4 gv = *(const f32x4*)(gain + j * 256 + lane * 4);
#pragma unroll
                    for (int i = 0; i < 4; ++i) { const float hn = xv[j][i] * rstd * gv[i]; const int k = j * 256 + lane * 4 + i;
                        const f32x4 r0 = *(LAS const f32x4*)(RT + k * 8), r1 = *(LAS const f32x4*)(RT + k * 8 + 4);
                        lg[0] += hn * r0[0]; lg[1] += hn * r0[1]; lg[2] += hn * r0[2]; lg[3] += hn * r0[3]; lg[4] += hn * r1[0]; lg[5] += hn * r1[1]; lg[6] += hn * r1[2]; lg[7] += hn * r1[3]; } }
#pragma unroll
                for (int e = 0; e < 8; ++e) {
#pragma unroll
                    for (int o = 32; o >= 1; o >>= 1) lg[e] += __shfl_xor(lg[e], o); }
                if (lane == 0) {
                    int e1 = 0; float v1 = lg[0];
#pragma unroll
                    for (int e = 1; e < 8; ++e) if (lg[e] > v1) { v1 = lg[e]; e1 = e; }
                    int e2 = -1; float v2 = -3.0e38f;
#pragma unroll
                    for (int e = 0; e < 8; ++e) if (e != e1 && lg[e] > v2) { v2 = lg[e]; e2 = e; }
                    if (e2 < 0) { e2 = (e1 + 1) & 7; v2 = v1; }
                    const float ex = __expf(v2 - v1), w1 = 1.0f / (1.0f + ex), w2 = ex / (1.0f + ex);
                    route[row * 8 + 0] = e1; route[row * 8 + 1] = e2; route[row * 8 + 2] = __float_as_int(w1); route[row * 8 + 3] = __float_as_int(w2);
                    EL[(s * 8 + wid) * 2] = e1; EL[(s * 8 + wid) * 2 + 1] = e2;
                }
            }
        }
          }
        if (MODE == 1) {
            __syncthreads();
            if (tid < 8) { int c = 0; for (int i = 0; i < 128; ++i) c += (EL[i] == tid) ? 1 : 0; ((int*)(P.ws + WS_HIST))[rb * 8 + tid] = c; }
            __syncthreads();
        }
    }
}

__device__ __forceinline__ void ph_moe_gather(LAS unsigned char* lds, const Params& P) {
    const int tid = otid(), wid = __builtin_amdgcn_readfirstlane(tid >> 6), lane = tid & 63;
    const int* hist = (const int*)(P.ws + WS_HIST); int* route = (int*)(P.ws + WS_ROUTE); int* tab = (int*)(P.ws + WS_TAB);
    int* rowtok = (int*)(P.ws + WS_ROWTOK);
    LAS int* RED = (LAS int*)lds;
    LAS int* TOT = RED + 1024;
    LAS int* ELS = TOT + 64;
    for (int rb = obid(); rb < NT / 64; rb += gridDim.x) {
        { const int e = tid & 7, part = tid >> 3; int sa = 0, sb = 0;
          for (int b2 = part; b2 < 256; b2 += 64) { const int v = hist[b2 * 8 + e]; sa += v; if (b2 < rb) sb += v; }
          RED[part * 8 + e] = sa; RED[512 + part * 8 + e] = sb; }
        __syncthreads();
        if (tid < 8) { int sa = 0, sb = 0; for (int p2 = 0; p2 < 64; ++p2) { sa += RED[p2 * 8 + tid]; sb += RED[512 + p2 * 8 + tid]; } TOT[tid] = sa; TOT[8 + tid] = sb; }
        __syncthreads();
        if (tid == 0) { int acc = 0; for (int e = 0; e < 8; ++e) { TOT[16 + e] = acc; TOT[32 + e] = acc * 256 + TOT[8 + e]; acc += (TOT[e] + 255) >> 8; } TOT[24] = acc;
            if (rb == 0) { for (int e = 0; e <= 8; ++e) tab[e] = TOT[16 + e]; } }
        if (tid < 128) ELS[tid] = route[(rb * 64 + (tid >> 1)) * 8 + (tid & 1)];
        __syncthreads();
        if (tid < 128) { const int e = ELS[tid]; int rk = 0; for (int i = 0; i < tid; ++i) rk += (ELS[i] == e) ? 1 : 0;
            const int slot = TOT[32 + e] + rk; ELS[128 + tid] = slot; route[(rb * 64 + (tid >> 1)) * 8 + 4 + (tid & 1)] = slot; }
        __syncthreads();
        if (tid < 128) rowtok[ELS[128 + tid]] = rb * 64 + (tid >> 1);
        for (int e = 0; e < 8; ++e) { const int r0 = TOT[16 + e] * 256 + TOT[e], r1 = TOT[16 + e + 1] * 256;
            for (int r = r0 + rb * 512 + tid; r < r1; r += 512 * 256) rowtok[r] = 0; }
        __syncthreads();
    }
}

#ifndef MIXNR
#define MIXNR 4
#endif
__device__ __forceinline__ void ph_mixnorm(const Params& P) {
    const int tid = otid(), wid = __builtin_amdgcn_readfirstlane(tid >> 6), lane = tid & 63;
    const bf16_t* mix = (const bf16_t*)(P.ws + WS_MIX); bf16_t* hb = (bf16_t*)(P.ws + WS_H);
    for (int row0 = obid() * 8 + wid; row0 < NT; row0 += gridDim.x * 8 * MIXNR) {
        u32x2 rc0[MIXNR][4], rc1[MIXNR][4], rc2[MIXNR][4]; u32x4 rpw[MIXNR], rcw[MIXNR];
#pragma unroll
        for (int q = 0; q < MIXNR; ++q) { const int row = row0 + q * gridDim.x * 8;
            if (row < NT) { const bf16_t* mr = mix + (size_t)row * 4096;
#pragma unroll
                for (int j = 0; j < 4; ++j) { rc0[q][j] = *(const u32x2*)(mr + j * 256 + lane * 4); rc1[q][j] = *(const u32x2*)(mr + 1024 + j * 256 + lane * 4); rc2[q][j] = *(const u32x2*)(mr + 2048 + j * 256 + lane * 4); }
                rpw[q] = *(const u32x4*)(mr + 3072 + lane * 8); rcw[q] = *(const u32x4*)(mr + 3584 + lane * 8); } }
#pragma unroll
        for (int q = 0; q < MIXNR; ++q) { const int row = row0 + q * gridDim.x * 8;
          if (row < NT) {
            float av[4][4], pv[8], cv[8];
            float sa = 0.f, sp = 0.f, sc = 0.f;
#pragma unroll
            for (int j = 0; j < 4; ++j) { const u32x2 c0 = rc0[q][j], c1 = rc1[q][j], c2 = rc2[q][j];
                av[j][0] = (__uint_as_float(c0.x << 16) + __uint_as_float(c1.x << 16)) + __uint_as_float(c2.x << 16);
                av[j][1] = (__uint_as_float(c0.x & 0xffff0000u) + __uint_as_float(c1.x & 0xffff0000u)) + __uint_as_float(c2.x & 0xffff0000u);
                av[j][2] = (__uint_as_float(c0.y << 16) + __uint_as_float(c1.y << 16)) + __uint_as_float(c2.y << 16);
                av[j][3] = (__uint_as_float(c0.y & 0xffff0000u) + __uint_as_float(c1.y & 0xffff0000u)) + __uint_as_float(c2.y & 0xffff0000u);
                sa += (av[j][0] * av[j][0] + av[j][1] * av[j][1]) + (av[j][2] * av[j][2] + av[j][3] * av[j][3]); }
            { const u32x4 pw = rpw[q], cw = rcw[q];
              const unsigned pa[4] = {pw.x, pw.y, pw.z, pw.w}, ca[4] = {cw.x, cw.y, cw.z, cw.w};
#pragma unroll
              for (int i = 0; i < 4; ++i) { pv[2 * i] = __uint_as_float(pa[i] << 16); pv[2 * i + 1] = __uint_as_float(pa[i] & 0xffff0000u); cv[2 * i] = __uint_as_float(ca[i] << 16); cv[2 * i + 1] = __uint_as_float(ca[i] & 0xffff0000u);
                  sp += pv[2 * i] * pv[2 * i] + pv[2 * i + 1] * pv[2 * i + 1]; sc += cv[2 * i] * cv[2 * i] + cv[2 * i + 1] * cv[2 * i + 1]; } }
#pragma unroll
            for (int o = 32; o >= 1; o >>= 1) { sa += __shfl_xor(sa, o); sp += __shfl_xor(sp, o); sc += __shfl_xor(sc, o); }
            const float ra = 1.0f / sqrtf(sa * (1.0f / 1024.f) + 1e-6f), rp = 1.0f / sqrtf(sp * (1.0f / 512.f) + 1e-6f), rc = 1.0f / sqrtf(sc * (1.0f / 512.f) + 1e-6f);
            bf16_t* hr = hb + (size_t)row * DM;
#pragma unroll
            for (int j = 0; j < 4; ++j) { u32x2 w; w.x = pg8::cvt_pk_bf16(av[j][0] * ra, av[j][1] * ra); w.y = pg8::cvt_pk_bf16(av[j][2] * ra, av[j][3] * ra); *(u32x2*)(hr + j * 256 + lane * 4) = w; }
            { u32x4 w; w.x = pg8::cvt_pk_bf16(pv[0] * rp, pv[1] * rp); w.y = pg8::cvt_pk_bf16(pv[2] * rp, pv[3] * rp); w.z = pg8::cvt_pk_bf16(pv[4] * rp, pv[5] * rp); w.w = pg8::cvt_pk_bf16(pv[6] * rp, pv[7] * rp); *(u32x4*)(hr + 1024 + lane * 8) = w; }
            { u32x4 w; w.x = pg8::cvt_pk_bf16(cv[0] * rc, cv[1] * rc); w.y = pg8::cvt_pk_bf16(cv[2] * rc, cv[3] * rc); w.z = pg8::cvt_pk_bf16(cv[4] * rc, cv[5] * rc); w.w = pg8::cvt_pk_bf16(cv[6] * rc, cv[7] * rc); *(u32x4*)(hr + 1536 + lane * 8) = w; }
          } }
    }
}

constexpr int POOL_PITCH = 272, POOL_SLAB = 48 * POOL_PITCH;
__device__ __forceinline__ float gelu_tanh(float x) { const float u = 0.7978845608028654f * (x + 0.044715f * x * x * x); const float e = __expf(2.0f * u); const float th = 1.0f - 2.0f / (e + 1.0f); return 0.5f * x * (1.0f + th); }
__device__ __forceinline__ void compress_item(LAS unsigned char* lds, const Params& P, int layer, int item) {
    const int tid = otid(), wid = __builtin_amdgcn_readfirstlane(tid >> 6), lane = tid & 63, r32 = lane & 31, hi = lane >> 5;
    const int j = item & 1, bg = (item >> 1) & 7, rb = item >> 4, b = bg >> 1, g = bg & 1;
    const bf16_t* proj = (const bf16_t*)(P.ws + WS_PROJ);
    const bf16_t* w2t = (const bf16_t*)(P.ws + WS_WC2) + (size_t)(layer * 2 + j) * 128 * 128;
    const float* b1 = (const float*)(P.ws + WS_B1) + (layer * 2 + j) * 128;
    bf16_t* kc = (bf16_t*)(P.ws + WS_KC) + (size_t)(j * 8 + bg) * 256 * 128;
    LAS float* RED = (LAS float*)lds;
    LAS bf16_t* HID = (LAS bf16_t*)(lds + 32768);
    const int nb = wid & 3, kh = wid >> 2, c = rb * 32 + r32;
    const int colbase = PC_KC + j * 256 + g * 128;
    f32x16 acc;
#pragma unroll
    for (int r = 0; r < 16; ++r) acc[r] = 0.f;
    {
        LAS unsigned char* slab = lds + 49152 + wid * (32 * POOL_PITCH);
        const u32x4* w1f = (const u32x4*)(P.ws + WS_WC1) + (size_t)(layer * 2 + j) * 32 * 4 * 8 * 64;
        const int rsub = lane >> 4, ch = lane & 15;
        bf16x8 st[8], fb[8];
#define CMP_GLOAD(l_) do { _Pragma("unroll") for (int it = 0; it < 8; ++it) { int tok_ = 16 * (rb * 32 + it * 4 + rsub) + (l_); tok_ = tok_ > SEQ - 1 ? SEQ - 1 : tok_; \
            st[it] = *(const bf16x8*)(proj + ((size_t)b * SEQ + tok_) * NPROJ + colbase + ch * 8); } } while (0)
#define CMP_BLOAD(l_) do { _Pragma("unroll") for (int dd = 0; dd < 8; ++dd) fb[dd] = __builtin_bit_cast(bf16x8, w1f[(((l_) * 4 + nb) * 8 + dd) * 64 + lane]); } while (0)
        const int l0 = 16 * kh;
        CMP_GLOAD(l0);
        for (int l = l0; l < l0 + 16; ++l) {
#pragma unroll
            for (int it = 0; it < 8; ++it) *(LAS bf16x8*)(slab + (it * 4 + rsub) * POOL_PITCH + ch * 16) = st[it];
            CMP_BLOAD(l);
            if (l + 1 < l0 + 16) CMP_GLOAD(l + 1);
            asm volatile("s_waitcnt lgkmcnt(0)" ::: "memory");
            bf16x8 fa[8];
#pragma unroll
            for (int dd = 0; dd < 8; ++dd) fa[dd] = *(LAS const bf16x8*)(slab + r32 * POOL_PITCH + (dd * 2 + hi) * 16);
#pragma unroll
            for (int dd = 0; dd < 8; ++dd) acc = __builtin_amdgcn_mfma_f32_32x32x16_bf16(fa[dd], fb[dd], acc, 0, 0, 0);
        }
#undef CMP_GLOAD
#undef CMP_BLOAD
    }
#pragma unroll
    for (int r = 0; r < 16; ++r) RED[(kh * 32 + at::crow(r, hi)) * 128 + nb * 32 + r32] = acc[r];
    __syncthreads();
#pragma unroll
    for (int i = 0; i < 8; ++i) { const int idx = tid + 512 * i, row = idx >> 7, n = idx & 127;
        const float v = gelu_tanh((RED[row * 128 + n] + RED[(32 + row) * 128 + n]) + b1[n]);
        unsigned u = __float_as_uint(v); u += 0x7FFFu + ((u >> 16) & 1u);
        HID[row * 136 + n] = (bf16_t)(u >> 16); }
    __syncthreads();
    if (wid < 4) {
        f32x16 a2;
#pragma unroll
        for (int r = 0; r < 16; ++r) a2[r] = 0.f;
        bf16x8 ha[8], hbv[8];
#pragma unroll
        for (int dd = 0; dd < 8; ++dd) { ha[dd] = *(LAS const bf16x8*)(HID + r32 * 136 + dd * 16 + hi * 8); hbv[dd] = *(const bf16x8*)(w2t + (size_t)(wid * 32 + r32) * 128 + dd * 16 + hi * 8); }
        __builtin_amdgcn_sched_barrier(0);
#pragma unroll
        for (int dd = 0; dd < 8; ++dd) a2 = __builtin_amdgcn_mfma_f32_32x32x16_bf16(ha[dd], hbv[dd], a2, 0, 0, 0);
#pragma unroll
        for (int r = 0; r < 16; ++r) { unsigned u = __float_as_uint(a2[r]); u += 0x7FFFu + ((u >> 16) & 1u);
            kc[(size_t)(rb * 32 + at::crow(r, hi)) * 128 + wid * 32 + r32] = (bf16_t)(u >> 16); }
    }
    __syncthreads();
}

__device__ __forceinline__ void cumsum_item(LAS unsigned char* lds, const Params& P, int layer, int bh) {
    const int tid = otid(), wid = __builtin_amdgcn_readfirstlane(tid >> 6), lane = tid & 63;
    const int b = bh >> 2, h = bh & 3;
    const float* gf = (const float*)(P.ws + WS_GF); float* cum = (float*)(P.ws + WS_CUM) + (size_t)bh * SEQ;
    const float fb = P.in[I_FB][layer * 4 + h];
    LAS float* WS = (LAS float*)lds;
    float v[8]; float run = 0.f;
#pragma unroll
    for (int i = 0; i < 8; ++i) { const float z = gf[((size_t)b * SEQ + tid * 8 + i) * 32 + 24 + h] + fb;
        const float ls = fminf(z, 0.f) - log1pf(__expf(-fabsf(z))); run += ls; v[i] = run; }
    float sc = run;
#pragma unroll
    for (int o = 1; o < 64; o <<= 1) { const float t = __shfl_up(sc, o); if (lane >= o) sc += t; }
    if (lane == 63) WS[wid] = sc;
    __syncthreads();
    float base = sc - run;
    for (int w = 0; w < wid; ++w) base += WS[w];
#pragma unroll
    for (int i = 0; i < 8; ++i) cum[tid * 8 + i] = (base + v[i]) * LOG2E;
    __syncthreads();
}

__device__ __forceinline__ void knorm_item(const Params& P, int witem) {
    const int lane = otid() & 63, rsub = lane >> 4, ch = lane & 15;
    const int bh = witem >> 6, T = witem & 63, b = bh >> 2, h = bh & 3;
    const bf16_t* kp = (const bf16_t*)(P.ws + WS_PROJ) + ((size_t)b * SEQ + T * 64 + rsub) * NPROJ + PC_FK + h * 128 + ch * 8;
    bf16x8 kv[16];
#pragma unroll
    for (int it = 0; it < 16; ++it) kv[it] = *(const bf16x8*)(kp + (size_t)(it * 4) * NPROJ);
    float mx = 0.f;
#pragma unroll
    for (int it = 0; it < 16; ++it) { float ss = 0.f;
#pragma unroll
        for (int e = 0; e < 8; ++e) { const float x = bf2f((bf16_t)kv[it][e]); ss += x * x; }
        ss += __shfl_xor(ss, 1); ss += __shfl_xor(ss, 2); ss += __shfl_xor(ss, 4); ss += __shfl_xor(ss, 8);
        mx = fmaxf(mx, ss); }
    mx = fmaxf(mx, __shfl_xor(mx, 16)); mx = fmaxf(mx, __shfl_xor(mx, 32));
    if (lane == 0) ((float*)(P.ws + WS_KSG))[bh * 64 + T] = sqrtf(mx);
}

__device__ __forceinline__ void pool_item(LAS unsigned char* lds, const Params& P, int layer, int witem) {
    const int tid = otid(), wid = __builtin_amdgcn_readfirstlane(tid >> 6), lane = tid & 63, r32 = lane & 31, hi = lane >> 5;
    const int gi = witem & 3, tb = witem >> 2;
    const int w = 2 << gi;
    const bf16_t* proj = (const bf16_t*)(P.ws + WS_PROJ); bf16_t* mix = (bf16_t*)(P.ws + WS_MIX);
    const u32x4* pwf = (const u32x4*)(P.ws + WS_WPOOL) + (size_t)(layer * 4 + gi) * 4 * 8 * 64;
    const float* psc = P.in[I_POOLS] + layer * 512 + gi * 128;
    LAS unsigned char* slab = lds + wid * POOL_SLAB;
    const int t0 = tb * 32, s0 = t0 & (SEQ - 1);
    { const int rsub = lane >> 4, ch = lane & 15;
#pragma unroll
      for (int it = 0; it < 12; ++it) { const int i = it * 4 + rsub; const int tok = t0 - 16 + i;
          if (s0 - 16 + i >= 0) { const bf16x8 v = *(const bf16x8*)(proj + (size_t)tok * NPROJ + PC_POOL + gi * 128 + ch * 8);
              *(LAS bf16x8*)(slab + i * POOL_PITCH + ch * 16) = v; } } }
    asm volatile("s_waitcnt lgkmcnt(0)" ::: "memory");
    const int s = s0 + r32;
    const int n = (s + 1) < w ? (s + 1) : w;
    const float invn = 1.0f / (float)n;
    bf16x8 afr[8];
#pragma unroll
    for (int d0 = 0; d0 < 8; ++d0) {
        LAS const unsigned char* up = slab + (16 + r32) * POOL_PITCH + (d0 * 2 + hi) * 16;
        float sum[8], cur[8];
        { const bf16x8 v = *(LAS const bf16x8*)up;
#pragma unroll
          for (int i = 0; i < 8; ++i) { cur[i] = bf2f((bf16_t)v[i]); sum[i] = cur[i]; } }
        for (int k = 1; k < n; ++k) { const bf16x8 v = *(LAS const bf16x8*)(up - k * POOL_PITCH);
#pragma unroll
            for (int i = 0; i < 8; ++i) sum[i] += bf2f((bf16_t)v[i]); }
        u32x4 wv;
        wv.x = pg8::cvt_pk_bf16(sum[0] * invn - cur[0], sum[1] * invn - cur[1]); wv.y = pg8::cvt_pk_bf16(sum[2] * invn - cur[2], sum[3] * invn - cur[3]);
        wv.z = pg8::cvt_pk_bf16(sum[4] * invn - cur[4], sum[5] * invn - cur[5]); wv.w = pg8::cvt_pk_bf16(sum[6] * invn - cur[6], sum[7] * invn - cur[7]);
        afr[d0] = *reinterpret_cast<bf16x8*>(&wv);
    }
#pragma unroll
    for (int nb = 0; nb < 4; ++nb) {
        f32x16 acc;
#pragma unroll
        for (int r = 0; r < 16; ++r) acc[r] = 0.f;
        bf16x8 bfr[8];
#pragma unroll
        for (int d0 = 0; d0 < 8; ++d0) bfr[d0] = __builtin_bit_cast(bf16x8, pwf[(nb * 8 + d0) * 64 + lane]);
        __builtin_amdgcn_sched_barrier(0);
#pragma unroll
        for (int d0 = 0; d0 < 8; ++d0) acc = __builtin_amdgcn_mfma_f32_32x32x16_bf16(afr[d0], bfr[d0], acc, 0, 0, 0);
        const float sc = psc[nb * 32 + r32];
#pragma unroll
        for (int r = 0; r < 16; ++r) { const float v = acc[r] * sc;
            const float vn = __int_as_float(__builtin_amdgcn_update_dpp(0, __float_as_int(v), 0xB1, 0xF, 0xF, true));
            if ((r32 & 1) == 0) *(unsigned*)(mix + (size_t)(tb * 32 + at::crow(r, hi)) * 4096 + 3072 + gi * 128 + nb * 32 + r32) = pg8::cvt_pk_bf16(v, vn); }
    }
}

constexpr int NPL = 10, NPH = 1 + DEPTH * NPL + 1;
constexpr int LDS_MISC = 131072, LDS_BYTES = LDS_MISC + 256;

__global__ void __launch_bounds__(512, 2) hymba_fwd(Params P) {
    extern __shared__ __attribute__((aligned(16))) unsigned char shm[];
    LAS unsigned char* lds = (LAS unsigned char*)shm;
    volatile LAS unsigned* MISC = (volatile LAS unsigned*)(lds + LDS_MISC);
    const int tid = otid(), wid = __builtin_amdgcn_readfirstlane(tid >> 6);
    const int G = gridDim.x, lo = P.ph_lo, hi = P.ph_hi;
    if (tid == 0) { MISC[0] = 0u; MISC[1] = 0u; MISC[2] = 0u; MISC[3] = 0u; }
    __syncthreads();
    unsigned char* ws = P.ws;
    XcdBarrier bar; bar.bar = (unsigned*)(ws + WS_CTL); bar.x = 0; bar.st = MISC;
    if (hi - lo > 1) bar = xcd_barrier_post((unsigned*)(ws + WS_CTL), MISC);
#define IN(k) (lo <= (k) && (k) < hi)
#define BAR_AFTER(k) do { if (IN(k) && (k) + 1 < hi) xcd_barrier(bar); } while (0)
    const float* x_in = P.in[I_X];
    bf16_t* xb = (bf16_t*)(ws + WS_X); bf16_t* hb = (bf16_t*)(ws + WS_H); bf16_t* proj = (bf16_t*)(ws + WS_PROJ); float* gf = (float*)(ws + WS_GF);
    bf16_t* act = (bf16_t*)(ws + WS_ACT); const int* tab = (const int*)(ws + WS_TAB);

    if (IN(0) && (PHM & 1)) for (int rep_ = 0; rep_ < ((REPM & 1) ? 2 : 1); ++rep_) { ph_prologue(lds, P); ph_norm<0, true>(lds, P, x_in, xb, false, nullptr, nullptr, nullptr, INPROJ_FP8 != 0); }
    BAR_AFTER(0);
    for (int l = 0; l < DEPTH; ++l) {
        const int pb = 1 + l * NPL, i2 = l >> 1; const bool moe = (l & 1) != 0;
        if (l > 0) {
        if (IN(pb + 0) && (PHM & 2)) for (int rep_ = 0; rep_ < (((REPM & 2) && l != 2) ? 2 : 1); ++rep_) ph_norm<0>(lds, P, nullptr, xb, l == 2, nullptr, nullptr, nullptr, INPROJ_FP8 != 0);
        BAR_AFTER(pb + 0);
        }
        if (IN(pb + 1) && (PHM & 4)) for (int rep_ = 0; rep_ < ((REPM & 4) ? 2 : 1); ++rep_) { pg8::StaticOrder S; S.init(NT, NPROJ, G, obid(), WGM_INPROJ);
#if INPROJ_FP8
            pg8::Gemm g{hb  , (const bf16_t*)(ws + WS_WIN + (size_t)l * NPROJ * DM), NT, NPROJ, DM / 2  , nullptr};
            pg8::EpiProj E{proj, gf, 1.0f / WSCALE8}; pg8::gemm_phase<pg8::EpiProj, pg8::StaticOrder, false, true>(lds, g, S, E); }
#else
            pg8::Gemm g{hb, (const bf16_t*)(ws + WS_WIN) + (size_t)l * NPROJ * DM, NT, NPROJ, DM, nullptr};
            pg8::EpiProj E{proj, gf, 1.0f}; pg8::gemm_phase<pg8::EpiProj, pg8::StaticOrder>(lds, g, S, E); }
#endif
        BAR_AFTER(pb + 1);
        if (IN(pb + 2) && (PHM & 8)) for (int rep_ = 0; rep_ < ((REPM & 8) ? 2 : 1); ++rep_) {
            for (int it = obid(); it < 128; it += G) compress_item(lds, P, l, it);
            for (int it = obid() - 128; it < 16; it += G) if (it >= 0) cumsum_item(lds, P, l, it);
            { unsigned* pcnt = (unsigned*)(ws + WS_CTL) + 8192 + 64 * (l * 2 + rep_);
              for (;;) { int it = 0; if ((otid() & 63) == 0) it = (int)__hip_atomic_fetch_add(pcnt, 1u, __ATOMIC_RELAXED, __HIP_MEMORY_SCOPE_AGENT);
                  it = __builtin_amdgcn_readfirstlane(it);
                  if (it >= 3072) break;
                  if (it < 1024) knorm_item(P, it); else pool_item(lds, P, l, it - 1024); } }
        }
        BAR_AFTER(pb + 2);
        if (IN(pb + 3) && (PHM & 16)) for (int rep_ = 0; rep_ < ((REPM & 16) ? 2 : 1); ++rep_) {
            unsigned* qcnt = (unsigned*)(ws + WS_CTL) + 4096 + 64 * (l * 2 + rep_);
            const int* ilist = (const int*)(ws + WS_ILIST);
            LAS int* QI = (LAS int*)(lds + at::OFF_Q);
            for (;;) {
                if (otid() == 0) QI[0] = (int)__hip_atomic_fetch_add(qcnt, 1u, __ATOMIC_RELAXED, __HIP_MEMORY_SCOPE_AGENT);
                __syncthreads();
                const int qi_ = QI[0];
                __syncthreads();
                if (qi_ >= 768) break;
                const int it = ilist[qi_];
                if (it < 512) nsa_item((LAS char*)lds, P, it >> 6, it & 63);
                else fox_item((LAS char*)lds, P, (it - 512) >> 4, (it - 512) & 15);
            }
        }
        BAR_AFTER(pb + 3);
        if (IN(pb + 4) && (PHM & 32)) for (int rep_ = 0; rep_ < ((REPM & 32) ? 2 : 1); ++rep_) ph_mixnorm(P);
        BAR_AFTER(pb + 4);
        if (IN(pb + 5) && (PHM & 64)) for (int rep_ = ((REPM & 64) ? 1 : 0); rep_ >= 0; --rep_) { pg8::Gemm g{hb, (const bf16_t*)(ws + WS_WOUT) + (size_t)l * DM * DM, NT, DM, DM, nullptr}; pg8::StaticOrder S; S.init(NT, DM, G, obid(), WGM_OUT);
            pg8::EpiResB E{l == 0 ? (const void*)x_in : (const void*)xb, l == 0 ? 1 : 0, rep_ ? (bf16_t*)(ws + WS_ACT) : xb, 1.0f}; pg8::gemm_phase<pg8::EpiResB, pg8::StaticOrder>(lds, g, S, E); }
        BAR_AFTER(pb + 5);
        if (IN(pb + 6) && (PHM & 128)) { if (moe) ph_norm<1>(lds, P, nullptr, xb, false, P.in[I_NORM2] + l * DM, P.in[I_ROUTER] + (size_t)i2 * DM * 8, nullptr, true);
                          else ph_norm<0>(lds, P, nullptr, xb, false, nullptr, nullptr, nullptr, true); }
        BAR_AFTER(pb + 6);
        if (moe) {
            if (IN(pb + 7) && (PHM & 256)) ph_moe_gather(lds, P);
            BAR_AFTER(pb + 7);
            if (IN(pb + 8) && (PHM & 512)) for (int rep_ = 0; rep_ < ((REPM & 512) ? 2 : 1); ++rep_) { pg8::Gemm g{hb  , (const bf16_t*)(ws + WS_WMGU + (size_t)i2 * 8 * 2 * DFE * DM), 0, 2 * DFE, DM / 2  , (const int*)(ws + WS_ROWTOK)}; pg8::GroupedOrder S; S.initg(tab, 2 * DFE, G, obid(), WGM_MUP);
                pg8::EpiSwiglu8 E{(unsigned char*)act, DFE, 1.0f / WSCALE8}; pg8::gemm_phase<pg8::EpiSwiglu8, pg8::GroupedOrder, true, true>(lds, g, S, E); }
            BAR_AFTER(pb + 8);
            if (IN(pb + 9) && (PHM & 1024)) for (int rep_ = 0; rep_ < ((REPM & 1024) ? 2 : 1); ++rep_) { pg8::Gemm g{act, (const bf16_t*)(ws + WS_WMD + (size_t)i2 * 8 * DM * DFE), 0, DM, DFE / 2, nullptr}; pg8::GroupedOrder S; S.initg(tab, DM, G, obid(), WGM_MDOWN);
                pg8::EpiFp8S E{(unsigned char*)(ws + WS_MIX)  , DM, 1.0f / WSCALE8}; pg8::gemm_phase<pg8::EpiFp8S, pg8::GroupedOrder, false, true>(lds, g, S, E); }
            BAR_AFTER(pb + 9);
        } else {
            if (IN(pb + 8) && (PHM & 2048)) for (int rep_ = 0; rep_ < ((REPM & 2048) ? 2 : 1); ++rep_) { pg8::Gemm g{hb, (const bf16_t*)(ws + WS_WFGU + (size_t)i2 * 2 * DFF * DM), NT, 2 * DFF, DM / 2, nullptr}; pg8::StaticOrder S; S.init(NT, 2 * DFF, G, obid(), WGM_FUP);
                pg8::EpiSwiglu8 E{(unsigned char*)act, DFF, 1.0f / WSCALE8}; pg8::gemm_phase<pg8::EpiSwiglu8, pg8::StaticOrder, false, true>(lds, g, S, E); }
            BAR_AFTER(pb + 8);
            if (IN(pb + 9) && (PHM & 4096)) for (int rep_ = ((REPM & 4096) ? 1 : 0); rep_ >= 0; --rep_) { pg8::Gemm g{act, (const bf16_t*)(ws + WS_WFD + (size_t)i2 * DM * DFF), NT, DM, DFF / 2, nullptr}; pg8::StaticOrder S; S.init(NT, DM, G, obid(), WGM_FDOWN);
                pg8::EpiResB E{(const void*)xb, 0, rep_ ? (bf16_t*)(ws + WS_PROJ) : xb, 1.0f / WSCALE8}; pg8::gemm_phase<pg8::EpiResB, pg8::StaticOrder, false, true>(lds, g, S, E); }
            BAR_AFTER(pb + 9);
        }
    }
    { int lo2 = P.ph_lo, hi2 = P.ph_hi; asm volatile("" : "+s"(lo2), "+s"(hi2));
    if (lo2 <= NPH - 1 && NPH - 1 < hi2 && (PHM & 8192)) ph_norm<2>(lds, P, nullptr, xb, true, P.in[I_FNORM], nullptr, P.out); }
#undef IN
#undef BAR_AFTER
}

extern "C" void kernel_launch(void* const* d_in, const int* in_sizes, int n_in, void* d_out, int out_size, void* d_ws, size_t ws_size, hipStream_t stream) {
    static int grid = 0;
    if (grid == 0) {
        if (n_in != 20 || out_size != NT * DM || ws_size < WS_END) { fprintf(stderr, "kernel_launch: unexpected shapes (n_in %d, out %d, ws %zu, need %zu)\n", n_in, out_size, ws_size, (size_t)WS_END); grid = -1; return; }
        int dev = 0, cus = 0, per_cu = 0;
        if (hipGetDevice(&dev) != hipSuccess || hipDeviceGetAttribute(&cus, hipDeviceAttributeMultiprocessorCount, dev) != hipSuccess) { grid = -1; return; }
        if (hipFuncSetAttribute((const void*)hymba_fwd, hipFuncAttributeMaxDynamicSharedMemorySize, LDS_BYTES) != hipSuccess) { fprintf(stderr, "kernel_launch: hipFuncSetAttribute failed\n"); grid = -1; return; }
        if (hipOccupancyMaxActiveBlocksPerMultiprocessor(&per_cu, (const void*)hymba_fwd, 512, LDS_BYTES) != hipSuccess || per_cu < 1) { fprintf(stderr, "kernel_launch: occupancy query says %d\n", per_cu); }
        (void)hipGetLastError();
        grid = cus;
    }
    if (grid < 0) return;
    (void)hipMemsetAsync((char*)d_ws + WS_CTL, 0, CTL_BYTES, stream);
    Params p{};
    for (int i = 0; i < 20; ++i) p.in[i] = (const float*)d_in[i];
    p.out = (float*)d_out; p.ws = (unsigned char*)d_ws;
#if MK_PER_PHASE
    for (int k = 0; k < NPH; ++k) { p.ph_lo = k; p.ph_hi = k + 1; hipLaunchKernelGGL(hymba_fwd, dim3(grid), dim3(512), LDS_BYTES, stream, p); }
#else
    p.ph_lo = 0; p.ph_hi = NPH;
    hipLaunchKernelGGL(hymba_fwd, dim3(grid), dim3(512), LDS_BYTES, stream, p);
#endif
}
```
